# Optimizing an MI355X kernel written in HIP

```python
import jax, jax.numpy as jnp
from jax import lax
import numpy as np


D_MODEL = 2048
BATCH = 8
SEQ = 2048
DEPTH = 1

POOL_GROUPS = 4
POOL_GROUP_DIM = 256
POOL_WIDTH = POOL_GROUPS * POOL_GROUP_DIM
POOL_WINDOWS = (2, 4, 8, 16)
N_HEADS = 8
HEAD_DIM = 128
V_HEAD_DIM = 2 * HEAD_DIM
QK_WIDTH = N_HEADS * 2 * HEAD_DIM
ATTN_WIDTH = N_HEADS * V_HEAD_DIM
ROT_DIM = HEAD_DIM // 4
ROT_HALF = ROT_DIM // 2
ROPE_THETA = 500000.0
Q_BLOCK = 128
ATTN_SCALE = HEAD_DIM ** -0.5
SUBLN_EPS = 1e-5
IN_WIDTH = POOL_WIDTH + 2 * QK_WIDTH + ATTN_WIDTH + 2 * D_MODEL
IN_SPLITS = (POOL_WIDTH,
             POOL_WIDTH + QK_WIDTH,
             POOL_WIDTH + 2 * QK_WIDTH,
             POOL_WIDTH + 2 * QK_WIDTH + ATTN_WIDTH,
             POOL_WIDTH + 2 * QK_WIDTH + ATTN_WIDTH + D_MODEL)
N_EXPERTS = 64
EXPERT_DIM = 512
SHARED_DIM = 512
TOP_K = 8
N_GROUPS = 8
TOPK_GROUPS = 4
EXPERTS_PER_GROUP = N_EXPERTS // N_GROUPS
ROUTED_SCALE = 2.5
MOE_BLOCK = 128
N_MOD = 6
NORM_EPS = 1e-6

kernel_name = "hybrid_pool_diffattn_moe_adaln_block"


def rms_norm(x, w, eps=NORM_EPS):
    xf = x.astype(jnp.float32)
    y = xf * lax.rsqrt(jnp.mean(xf * xf, axis=-1, keepdims=True) + eps)
    return (y * w.astype(jnp.float32)).astype(x.dtype)


def rotary_tables(seq_len):
    pos = jnp.arange(seq_len, dtype=jnp.float32)
    inv_freq = 1.0 / (ROPE_THETA ** (jnp.arange(0, ROT_DIM, 2, dtype=jnp.float32) / ROT_DIM))
    ang = pos[:, None] * inv_freq[None, :]
    return jnp.cos(ang), jnp.sin(ang)


def partial_rope(t, cos, sin):
    tf = t.astype(jnp.float32)
    r1 = tf[..., :ROT_HALF]
    r2 = tf[..., ROT_HALF:ROT_DIM]
    cb = cos[:, None, None, :]
    sb = sin[:, None, None, :]
    out = jnp.concatenate([r1 * cb - r2 * sb, r2 * cb + r1 * sb, tf[..., ROT_DIM:]], axis=-1)
    return out.astype(t.dtype)


def pool_mixer(u, pool_w, pool_scale):
    b_, s_, _ = u.shape
    ug = u.reshape(b_, s_, POOL_GROUPS, POOL_GROUP_DIM).astype(jnp.float32)
    cs = jnp.concatenate([jnp.zeros_like(ug[:, :1]), jnp.cumsum(ug, axis=1)], axis=1)
    t = jnp.arange(s_)[:, None]
    win = jnp.array(POOL_WINDOWS, dtype=jnp.int32)[None, :]
    lo = jnp.maximum(t + 1 - win, 0)
    cnt = jnp.minimum(t + 1, win).astype(jnp.float32)
    cs_lo = cs[:, lo, jnp.arange(POOL_GROUPS)[None, :], :]
    mean = (cs[:, 1:] - cs_lo) / cnt[None, :, :, None]
    mixed = (mean - ug).astype(u.dtype)
    y = jnp.einsum('bsgc,gce->bsge', mixed, pool_w) * pool_scale
    return y.reshape(b_, s_, POOL_WIDTH)


def diff_attention(q, k, v, lq1, lk1, lq2, lk2, subln_w, lambda_init, cos, sin):
    b_, s_, _ = q.shape
    q = partial_rope(q.reshape(b_, s_, N_HEADS, 2, HEAD_DIM), cos, sin)
    k = partial_rope(k.reshape(b_, s_, N_HEADS, 2, HEAD_DIM), cos, sin)
    v = v.reshape(b_, s_, N_HEADS, V_HEAD_DIM)
    lam = (jnp.exp(jnp.sum(lq1.astype(jnp.float32) * lk1.astype(jnp.float32)))
           - jnp.exp(jnp.sum(lq2.astype(jnp.float32) * lk2.astype(jnp.float32)))
           + lambda_init)
    nq = s_ // Q_BLOCK
    q_blocks = jnp.moveaxis(q.reshape(b_, nq, Q_BLOCK, N_HEADS, 2, HEAD_DIM), 1, 0)
    q_pos = jnp.arange(s_).reshape(nq, Q_BLOCK)
    k_pos = jnp.arange(s_)

    def attend(args):
        qb, qp = args
        s = jnp.einsum('bqhcd,bkhcd->cbhqk', qb, k, preferred_element_type=jnp.float32) * ATTN_SCALE
        s = jnp.where(qp[:, None] >= k_pos[None, :], s, -jnp.inf)
        p = jax.nn.softmax(s, axis=-1)
        a = (p[0] - lam * p[1]).astype(v.dtype)
        return jnp.einsum('bhqk,bkhe->bqhe', a, v)

    o = lax.map(attend, (q_blocks, q_pos))
    o = jnp.moveaxis(o, 0, 1).reshape(b_, s_, N_HEADS, V_HEAD_DIM)
    o = rms_norm(o, subln_w, SUBLN_EPS) * (1.0 - lambda_init)
    return o.reshape(b_, s_, ATTN_WIDTH)


def hybrid_mixer(h, w_in, pool_w, pool_scale, w_branch_pool, lq1, lk1, lq2, lk2,
                 subln_w, w_branch_attn, w_out, lambda_init, cos, sin):
    proj = jnp.einsum('bsd,de->bse', h, w_in)
    u, q, k, v, g_pool, g_attn = jnp.split(proj, IN_SPLITS, axis=-1)
    y_pool = jnp.einsum('bsp,pd->bsd', pool_mixer(u, pool_w, pool_scale), w_branch_pool)
    y_attn = jnp.einsum('bsa,ad->bsd',
                        diff_attention(q, k, v, lq1, lk1, lq2, lk2, subln_w, lambda_init, cos, sin),
                        w_branch_attn)
    merged = jax.nn.sigmoid(g_pool) * y_pool + jax.nn.sigmoid(g_attn) * y_attn
    return jnp.einsum('bsd,de->bse', merged, w_out)


def swiglu(x, wg, wu, wd):
    return (jax.nn.silu(x @ wg) * (x @ wu)) @ wd


def moe_ffn(h, w_router, router_bias, w_gate_e, w_up_e, w_down_e, w_sh_gate, w_sh_up, w_sh_down):
    b_, s_, d_ = h.shape
    n = b_ * s_
    xf = h.reshape(n, d_)
    scores = jax.nn.sigmoid(jnp.einsum('nd,de->ne', xf, w_router, preferred_element_type=jnp.float32))
    biased = scores + router_bias.astype(jnp.float32)
    grp_score = lax.top_k(biased.reshape(n, N_GROUPS, EXPERTS_PER_GROUP), 2)[0].sum(-1)
    _, top_groups = lax.top_k(grp_score, TOPK_GROUPS)
    group_mask = jnp.any(top_groups[..., None] == jnp.arange(N_GROUPS), axis=-2)
    expert_mask = jnp.repeat(group_mask, EXPERTS_PER_GROUP, axis=-1)
    _, expert_idx = lax.top_k(jnp.where(expert_mask, biased, -jnp.inf), TOP_K)
    sel = jnp.take_along_axis(scores, expert_idx, axis=-1)
    gates = sel / jnp.sum(sel, axis=-1, keepdims=True) * ROUTED_SCALE

    n_assign = n * TOP_K
    n_slots = (n_assign + N_EXPERTS * (MOE_BLOCK - 1) + MOE_BLOCK - 1) // MOE_BLOCK * MOE_BLOCK
    n_blocks = n_slots // MOE_BLOCK
    e_flat = expert_idx.reshape(-1)
    tok_flat = jnp.repeat(jnp.arange(n, dtype=jnp.int32), TOP_K)
    g_flat = gates.reshape(-1)
    order = jnp.argsort(e_flat)
    e_sorted = e_flat[order]
    counts = jnp.bincount(e_flat, length=N_EXPERTS)
    padded = (counts + MOE_BLOCK - 1) // MOE_BLOCK * MOE_BLOCK
    pad_end = jnp.cumsum(padded)
    pad_start = pad_end - padded
    start = jnp.cumsum(counts) - counts
    dest = pad_start[e_sorted] + (jnp.arange(n_assign) - start[e_sorted])
    slot_tok = jnp.full((n_slots,), n, jnp.int32).at[dest].set(tok_flat[order])
    slot_gate = jnp.zeros((n_slots,), jnp.float32).at[dest].set(g_flat[order])
    block_expert = jnp.minimum(
        jnp.searchsorted(pad_end, jnp.arange(n_blocks) * MOE_BLOCK, side='right'), N_EXPERTS - 1)
    x_pad = jnp.concatenate([xf, jnp.zeros((1, d_), xf.dtype)], axis=0)

    def expert_block(args):
        toks, gts, e = args
        xb = x_pad[toks]
        yb = swiglu(xb, w_gate_e[e], w_up_e[e], w_down_e[e])
        return yb * gts[:, None].astype(yb.dtype)

    y_slots = lax.map(expert_block, (slot_tok.reshape(n_blocks, MOE_BLOCK),
                                     slot_gate.reshape(n_blocks, MOE_BLOCK), block_expert))
    routed = jnp.zeros((n + 1, d_), xf.dtype).at[slot_tok].add(y_slots.reshape(n_slots, d_))[:n]
    shared = swiglu(xf, w_sh_gate, w_sh_up, w_sh_down)
    return (shared + routed).reshape(b_, s_, d_)


def setup_inputs(seed: int = 0) -> dict:
    key = jax.random.key(seed)
    ks = jax.random.split(key, 26)
    L, D = DEPTH, D_MODEL

    def nrm(k, shape, scale):
        return jax.random.normal(k, shape, jnp.float32) * scale

    return {
        "x": nrm(ks[0], (BATCH, SEQ, D), 1.0),
        "c": nrm(ks[1], (BATCH, D), 1.0),
        "w_ada": nrm(ks[2], (L, D, N_MOD * D), 0.5 * D ** -0.5),
        "b_ada": nrm(ks[3], (L, N_MOD * D), 0.02),
        "norm1_w": 1.0 + nrm(ks[4], (L, D), 0.05),
        "w_in": nrm(ks[5], (L, D, IN_WIDTH), D ** -0.5),
        "pool_w": nrm(ks[6], (L, POOL_GROUPS, POOL_GROUP_DIM, POOL_GROUP_DIM), POOL_GROUP_DIM ** -0.5),
        "pool_scale": 1.0 + nrm(ks[7], (L, POOL_GROUPS, POOL_GROUP_DIM), 0.1),
        "w_branch_pool": nrm(ks[8], (L, POOL_WIDTH, D), POOL_WIDTH ** -0.5),
        "lambda_q1": nrm(ks[9], (L, HEAD_DIM), 0.1),
        "lambda_k1": nrm(ks[10], (L, HEAD_DIM), 0.1),
        "lambda_q2": nrm(ks[11], (L, HEAD_DIM), 0.1),
        "lambda_k2": nrm(ks[12], (L, HEAD_DIM), 0.1),
        "subln_w": 1.0 + nrm(ks[13], (L, V_HEAD_DIM), 0.05),
        "w_branch_attn": nrm(ks[14], (L, ATTN_WIDTH, D), ATTN_WIDTH ** -0.5),
        "w_out": nrm(ks[15], (L, D, D), D ** -0.5),
        "norm2_w": 1.0 + nrm(ks[16], (L, D), 0.05),
        "w_router": nrm(ks[17], (L, D, N_EXPERTS), D ** -0.5),
        "router_bias": nrm(ks[18], (L, N_EXPERTS), 0.01),
        "w_gate_e": nrm(ks[19], (L, N_EXPERTS, D, EXPERT_DIM), D ** -0.5),
        "w_up_e": nrm(ks[20], (L, N_EXPERTS, D, EXPERT_DIM), D ** -0.5),
        "w_down_e": nrm(ks[21], (L, N_EXPERTS, EXPERT_DIM, D), EXPERT_DIM ** -0.5),
        "w_sh_gate": nrm(ks[22], (L, D, SHARED_DIM), D ** -0.5),
        "w_sh_up": nrm(ks[23], (L, D, SHARED_DIM), D ** -0.5),
        "w_sh_down": nrm(ks[24], (L, SHARED_DIM, D), SHARED_DIM ** -0.5),
        "final_norm_w": 1.0 + nrm(ks[25], (D,), 0.05),
    }


def reference(x, c, w_ada, b_ada, norm1_w, w_in, pool_w, pool_scale, w_branch_pool,
              lambda_q1, lambda_k1, lambda_q2, lambda_k2, subln_w, w_branch_attn, w_out,
              norm2_w, w_router, router_bias, w_gate_e, w_up_e, w_down_e,
              w_sh_gate, w_sh_up, w_sh_down, final_norm_w):
    cos, sin = rotary_tables(x.shape[1])
    c_act = jax.nn.silu(c)
    for l in range(DEPTH):
        lambda_init = 0.8 - 0.6 * float(np.exp(-0.3 * l))
        mod = jnp.einsum('bd,de->be', c_act, w_ada[l]) + b_ada[l]
        sh1, sc1, g1, sh2, sc2, g2 = jnp.split(mod[:, None, :], N_MOD, axis=-1)
        h = rms_norm(x, norm1_w[l]) * (1.0 + sc1) + sh1
        x = x + g1 * hybrid_mixer(h, w_in[l], pool_w[l], pool_scale[l], w_branch_pool[l],
                                  lambda_q1[l], lambda_k1[l], lambda_q2[l], lambda_k2[l],
                                  subln_w[l], w_branch_attn[l], w_out[l], lambda_init, cos, sin)
        h = rms_norm(x, norm2_w[l]) * (1.0 + sc2) + sh2
        x = x + g2 * moe_ffn(h, w_router[l], router_bias[l], w_gate_e[l], w_up_e[l], w_down_e[l],
                             w_sh_gate[l], w_sh_up[l], w_sh_down[l])
    return rms_norm(x, final_norm_w)
```

```cpp
#include <hip/hip_runtime.h>
#include <stdint.h>

typedef unsigned short bf16_t;
#define DEV __device__ __forceinline__

constexpr int T = 16384, D = 2048, SEQ = 2048, NBATCH = 8, INW = 11264, NE = 64, ED = 512, TOPK = 8;
constexpr float NORM_EPS = 1e-6f, SUBLN_EPS = 1e-5f, LAMBDA_INIT = 0.2f;

DEV float bf2f(bf16_t v) { return __uint_as_float(((unsigned)v) << 16); }
DEV bf16_t f2bf(float f) { unsigned u = __float_as_uint(f); u += 0x7FFFu + ((u >> 16) & 1u); return (bf16_t)(u >> 16); }
DEV float sigm(float x) { return 1.0f / (1.0f + expf(-x)); }
DEV float wave_sum(float v) { for (int o = 32; o >= 1; o >>= 1) v += __shfl_xor(v, o); return v; }
DEV float wave_max(float v) { for (int o = 32; o >= 1; o >>= 1) v = fmaxf(v, __shfl_xor(v, o)); return v; }

constexpr size_t MiB = 1024 * 1024;
constexpr size_t OFF_CTRL = 0;
constexpr size_t OFF_MOD = 64 * 1024;
constexpr size_t OFF_ROPE = OFF_MOD + 8 * 12288 * 4;
constexpr size_t OFF_EIDX = 1 * MiB;
constexpr size_t OFF_GATE = OFF_EIDX + 512 * 1024;
constexpr size_t OFF_LIST = 2 * MiB;
constexpr size_t OFF_WRT = 6 * MiB;
constexpr size_t OFF_POSIN = OFF_WRT + 512 * 1024;
constexpr size_t OFF_WEXP = 8 * MiB;
constexpr size_t OFF_ACT0 = 398 * MiB;
constexpr size_t OFF_WMIX = OFF_ACT0;
constexpr size_t OFF_H = OFF_ACT0 + 65 * MiB;
constexpr size_t OFF_MIXED = OFF_H;
constexpr size_t OFF_U = OFF_H + 64 * MiB;
constexpr size_t OFF_Q = OFF_U + 32 * MiB;
constexpr size_t OFF_K = OFF_Q + 64 * MiB;
constexpr size_t OFF_V = OFF_K + 64 * MiB;
constexpr size_t OFF_SGP = OFF_V + 64 * MiB;
constexpr size_t OFF_SGA = OFF_SGP + 64 * MiB;
constexpr size_t OFF_POOLO = OFF_SGA + 64 * MiB;
constexpr size_t OFF_ATTNO = OFF_POOLO + 32 * MiB;
constexpr size_t OFF_VT = OFF_ATTNO + 64 * MiB;
constexpr size_t OFF_X1B = OFF_ATTNO;
constexpr size_t OFF_W8G = OFF_WMIX;
constexpr size_t OFF_H8 = OFF_VT + 8 * MiB;
constexpr size_t OFF_W8O = OFF_VT + 40 * MiB;
constexpr size_t OFF_W8P = OFF_VT + 44 * MiB;
constexpr size_t OFF_W8A = OFF_VT + 46 * MiB;
constexpr size_t OFF_YPOOL = OFF_Q;
constexpr size_t OFF_MERGED = OFF_K;
constexpr size_t OFF_H2 = OFF_ACT0;
constexpr size_t OFF_ACT = OFF_H2 + 64 * MiB;
constexpr size_t OFF_YSLOT = OFF_ACT + 145 * MiB;
constexpr size_t WS_NEED = OFF_VT + 64 * MiB;

constexpr int C_CNT = 4096;
constexpr int C_ROWBASE = 4352;
constexpr int C_TSTART = 4480;

constexpr int TB_CNT = 0, TB_ROWBASE = 64, TB_TSTART = 160;
#define LAS __attribute__((address_space(3)))
typedef short bf16x8 __attribute__((ext_vector_type(8)));
typedef float f32x4 __attribute__((ext_vector_type(4)));
typedef float f32x16 __attribute__((ext_vector_type(16)));
typedef unsigned u32x4 __attribute__((ext_vector_type(4)));
typedef unsigned u32x2 __attribute__((ext_vector_type(2)));
namespace mg {
constexpr int BM = 256, BK = 64, HALF = 128, HTB = HALF * BK * 2, STAGE_BYTES = 8 * HTB, NXCD = 8, WGM = 8;
__host__ __device__ __forceinline__ int lds_byte(int r, int c) { const int st = (r >> 4) * 2 + (c >> 5), rr = r & 15, cc = c & 31, ob = rr * 64 + cc * 2; return st * 1024 + (ob ^ (((ob >> 9) & 1) << 5)); }
__host__ __device__ __forceinline__ void stage_rc(int b, int& R, int& C) { const int st = b / 1024, sb = b % 1024, swz = sb ^ (((sb >> 9) & 1) << 5); R = (st >> 1) * 16 + swz / 64; C = (st & 1) * 32 + (swz % 64) / 2; }
__host__ __device__ __forceinline__ int perm32(int rho) { const int n = rho >> 4, i = rho & 15; return 8 * (i >> 2) + 4 * n + (i & 3); }
DEV unsigned cvt_pk_bf16(float lo, float hi) { unsigned r; asm volatile("v_cvt_pk_bf16_f32 %0, %1, %2" : "=v"(r) : "v"(lo), "v"(hi)); return r; }

struct Unit { int pm, pn, e, rows, base; };

typedef int v8i32 __attribute__((ext_vector_type(8)));
typedef int v4i32 __attribute__((ext_vector_type(4)));
DEV v8i32 cat8(const bf16x8 a, const bf16x8 b) { const v4i32 x = (v4i32)a, y = (v4i32)b; return __builtin_shufflevector(x, y, 0, 1, 2, 3, 4, 5, 6, 7); }
template <class Epi, class Sched, bool F8 = false>
__device__ __forceinline__ void gemm_phase(LAS unsigned char* lds, const char* Abase, const int K, const Sched& S, const Epi& E) {
    const int tid = threadIdx.x, wid = __builtin_amdgcn_readfirstlane(tid >> 6), lane = tid & 63, wr = wid >> 2, wc = wid & 3, fr = lane & 15, fq = lane >> 4;
    const int KBy = F8 ? K : 2 * K, nt = KBy / 128;
    int Rs[2], Cs[2]; unsigned voffB[2];
#pragma unroll
    for (int i = 0; i < 2; ++i) { stage_rc(tid * 16 + i * 8192, Rs[i], Cs[i]); Cs[i] *= 2; const int Rb = Epi::PERM ? ((Rs[i] & ~31) + perm32(Rs[i] & 31)) : Rs[i]; voffB[i] = Sched::BTILED ? (unsigned)(tid * 16 + i * 8192) : (unsigned)(Rb * KBy + Cs[i]); }
    const size_t kstep = (size_t)(BK * 2);
    const size_t kstepB = Sched::BTILED ? (size_t)HTB : kstep;
    const size_t hstepB = Sched::BTILED ? (size_t)nt * HTB : (size_t)HALF * KBy;
    const unsigned ldsw = (unsigned)wid * 1024u;
    const int aoff = lds_byte(wr * 64 + fr, fq * 8), boff = lds_byte(wc * 32 + fr, fq * 8);
#define MG_SA(b, h) (((b) * 2 + (h)) * HTB)
#define MG_SB(b, h) ((4 + (b) * 2 + (h)) * HTB)
#define MG_STAGEB(bufoff, gbase) do { _Pragma("unroll") for (int _i = 0; _i < 2; ++_i) \
        __builtin_amdgcn_global_load_lds((const unsigned*)((const char*)(gbase) + voffB[_i]), (LAS unsigned*)(lds + (bufoff) + ldsw + _i * 8192), 16, 0, 0); } while (0)
#define MG_STAGEA(bufoff, koff, o0, o1) do { \
        __builtin_amdgcn_global_load_lds((const unsigned*)(Abase + (koff) + (o0)), (LAS unsigned*)(lds + (bufoff) + ldsw), 16, 0, 0); \
        __builtin_amdgcn_global_load_lds((const unsigned*)(Abase + (koff) + (o1)), (LAS unsigned*)(lds + (bufoff) + ldsw + 8192), 16, 0, 0); } while (0)
#define MG_LDA(dst, b, h) do { _Pragma("unroll") for (int m = 0; m < 4; ++m) _Pragma("unroll") for (int k = 0; k < 2; ++k) dst[m][k] = *(const LAS bf16x8*)(lds + MG_SA(b, h) + aoff + m * 2048 + k * 1024); } while (0)
#define MG_LDB(dst, b, h) do { _Pragma("unroll") for (int n = 0; n < 2; ++n) _Pragma("unroll") for (int k = 0; k < 2; ++k) dst[n][k] = *(const LAS bf16x8*)(lds + MG_SB(b, h) + boff + n * 2048 + k * 1024); } while (0)
#define MG_MMA(ai, bj, At, Bt) do { __builtin_amdgcn_s_setprio(1); _Pragma("unroll") for (int m = 0; m < 4; ++m) _Pragma("unroll") for (int n = 0; n < 2; ++n) { \
        if constexpr (F8) { const v8i32 b8_ = cat8(Bt[n][0], Bt[n][1]), a8_ = cat8(At[m][0], At[m][1]); asm volatile("v_mfma_f32_16x16x128_f8f6f4 %0, %1, %2, %0" : "+v"(acc[ai][bj][m][n]) : "v"(b8_), "v"(a8_)); } \
        else { _Pragma("unroll") for (int k = 0; k < 2; ++k) acc[ai][bj][m][n] = __builtin_amdgcn_mfma_f32_16x16x32_bf16(Bt[n][k], At[m][k], acc[ai][bj][m][n], 0, 0, 0); } } __builtin_amdgcn_s_setprio(0); } while (0)
#define MG_WAIT_V(n) asm volatile("s_waitcnt vmcnt(" #n ")" ::: "memory")
#define MG_WAIT_L(n) asm volatile("s_waitcnt lgkmcnt(" #n ")" ::: "memory")
#define MG_BAR __builtin_amdgcn_s_barrier()
#define MG_SCHED __builtin_amdgcn_sched_barrier(0)
    Unit cur, nxt; int ui = 0;
    if (!S.next(0, cur)) return;
    f32x4 acc[2][2][4][2];
#pragma unroll
    for (int a = 0; a < 2; ++a)
#pragma unroll
        for (int b = 0; b < 2; ++b)
#pragma unroll
            for (int m = 0; m < 4; ++m)
#pragma unroll
                for (int n = 0; n < 2; ++n) acc[a][b][m][n] = (f32x4){0.f, 0.f, 0.f, 0.f};
    bf16x8 At[4][2], B0[2][2], B1[2][2];
    unsigned c00 = S.a_off(cur, 0, Rs[0], Cs[0]), c01 = S.a_off(cur, 0, Rs[1], Cs[1]), c10 = S.a_off(cur, 1, Rs[0], Cs[0]), c11 = S.a_off(cur, 1, Rs[1], Cs[1]);
    unsigned n00 = c00, n01 = c01, n10 = c10, n11 = c11;
    const char* cB = S.b_ptr(cur);
    MG_STAGEB(MG_SB(0, 0), cB); MG_STAGEA(MG_SA(0, 0), 0, c00, c01); MG_STAGEB(MG_SB(0, 1), cB + hstepB); MG_STAGEA(MG_SA(0, 1), 0, c10, c11);
    if (wr == 1) MG_BAR;
    MG_WAIT_V(4); MG_BAR;
    MG_STAGEB(MG_SB(1, 0), cB + kstepB); MG_STAGEA(MG_SA(1, 0), kstep, c00, c01); MG_STAGEB(MG_SB(1, 1), cB + hstepB + kstepB);
    MG_WAIT_V(6); MG_BAR;
    for (;;) {
        const bool has_next = S.next(ui + 1, nxt);
        const char* nB = has_next ? S.b_ptr(nxt) : cB;
        if (has_next) { n00 = S.a_off(nxt, 0, Rs[0], Cs[0]); n01 = S.a_off(nxt, 0, Rs[1], Cs[1]); n10 = S.a_off(nxt, 1, Rs[0], Cs[0]); n11 = S.a_off(nxt, 1, Rs[1], Cs[1]); }
        else { n00 = c00; n01 = c01; n10 = c10; n11 = c11; }
#pragma unroll 1
        for (int t = 0; t < nt; t += 2) {
            const bool last = (t == nt - 2);
            const size_t k1 = (size_t)(t + 1) * kstep;
            const size_t k2 = last ? 0 : (size_t)(t + 2) * kstep, k3 = k2 + kstep;
            const unsigned x00 = last ? n00 : c00, x01 = last ? n01 : c01, x10 = last ? n10 : c10, x11 = last ? n11 : c11;
            const char* b2 = last ? nB : cB + (size_t)(t + 2) * kstepB; const char* b3 = b2 + kstepB;
            MG_LDB(B0, 0, 0); MG_SCHED; MG_LDA(At, 0, 0); MG_STAGEA(MG_SA(1, 1), k1, c10, c11);
            MG_WAIT_L(8); MG_BAR; MG_WAIT_L(0); MG_MMA(0, 0, At, B0); MG_BAR; MG_SCHED;
            MG_LDB(B1, 0, 1); MG_STAGEB(MG_SB(0, 0), b2);
            MG_BAR; MG_WAIT_L(0); MG_MMA(0, 1, At, B1); MG_BAR;
            MG_LDA(At, 0, 1); MG_STAGEA(MG_SA(0, 0), k2, x00, x01);
            MG_BAR; MG_WAIT_L(0); MG_MMA(1, 0, At, B0); MG_BAR; MG_SCHED;
            MG_STAGEB(MG_SB(0, 1), b2 + hstepB);
            MG_WAIT_V(6); MG_BAR; MG_MMA(1, 1, At, B1); MG_BAR;
            MG_LDB(B0, 1, 0); MG_SCHED; MG_LDA(At, 1, 0); MG_STAGEA(MG_SA(0, 1), k2, x10, x11);
            MG_WAIT_L(8); MG_BAR; MG_WAIT_L(0); MG_MMA(0, 0, At, B0); MG_BAR; MG_SCHED;
            MG_LDB(B1, 1, 1); MG_STAGEB(MG_SB(1, 0), b3);
            MG_BAR; MG_WAIT_L(0); MG_MMA(0, 1, At, B1); MG_BAR;
            MG_LDA(At, 1, 1); MG_STAGEA(MG_SA(1, 0), k3, x00, x01);
            MG_BAR; MG_WAIT_L(0); MG_MMA(1, 0, At, B0); MG_BAR; MG_SCHED;
            MG_STAGEB(MG_SB(1, 1), b3 + hstepB);
            MG_WAIT_V(6); MG_BAR; MG_MMA(1, 1, At, B1); MG_BAR;
        }
        if constexpr (F8) { asm volatile("s_nop 15\n\ts_nop 15" : "+v"(acc[0][0][0][0]), "+v"(acc[0][0][0][1]), "+v"(acc[0][0][1][0]), "+v"(acc[0][0][1][1]), "+v"(acc[0][0][2][0]), "+v"(acc[0][0][2][1]), "+v"(acc[0][0][3][0]), "+v"(acc[0][0][3][1]), "+v"(acc[0][1][0][0]), "+v"(acc[0][1][0][1]), "+v"(acc[0][1][1][0]), "+v"(acc[0][1][1][1]), "+v"(acc[0][1][2][0]), "+v"(acc[0][1][2][1]), "+v"(acc[0][1][3][0]), "+v"(acc[0][1][3][1]) :: "memory"); asm volatile("" : "+v"(acc[1][0][0][0]), "+v"(acc[1][0][0][1]), "+v"(acc[1][0][1][0]), "+v"(acc[1][0][1][1]), "+v"(acc[1][0][2][0]), "+v"(acc[1][0][2][1]), "+v"(acc[1][0][3][0]), "+v"(acc[1][0][3][1]), "+v"(acc[1][1][0][0]), "+v"(acc[1][1][0][1]), "+v"(acc[1][1][1][0]), "+v"(acc[1][1][1][1]), "+v"(acc[1][1][2][0]), "+v"(acc[1][1][2][1]), "+v"(acc[1][1][3][0]), "+v"(acc[1][1][3][1]) :: "memory"); }
        E(acc, cur, wr, wc, fr, fq);
        if (!has_next) break;
#pragma unroll
        for (int a = 0; a < 2; ++a)
#pragma unroll
            for (int b = 0; b < 2; ++b)
#pragma unroll
                for (int m = 0; m < 4; ++m)
#pragma unroll
                    for (int n = 0; n < 2; ++n) acc[a][b][m][n] = (f32x4){0.f, 0.f, 0.f, 0.f};
        cur = nxt; cB = nB; c00 = n00; c01 = n01; c10 = n10; c11 = n11; ++ui;
    }
    MG_WAIT_V(0);
    if (wr == 0) MG_BAR;
    MG_BAR;
#undef MG_SA
#undef MG_SB
#undef MG_STAGEA
#undef MG_STAGEB
#undef MG_LDA
#undef MG_LDB
#undef MG_MMA
#undef MG_WAIT_V
#undef MG_WAIT_L
#undef MG_BAR
#undef MG_SCHED
}

template <bool BT, int ELT = 2> struct DenseSchedT {
    static constexpr bool BTILED = BT;
    int nM, nN, nwg, G, c; int lda, acol; const char* Bt; int K;
    DEV void init(int M, int N, int G_, int c_, int lda_, int acol_, const void* Bt_, int K_) { nM = M / BM; nN = N / BM; nwg = nM * nN; G = G_; c = c_; lda = lda_; acol = acol_; Bt = (const char*)Bt_; K = K_; }
    DEV bool next(int i, Unit& u) const {
        const long L = (long)i * G + c; if (L >= nwg) return false;
        int wgid = (int)L; { const int q = nwg / NXCD, r = nwg % NXCD, xcd = wgid % NXCD, off = wgid / NXCD; wgid = (xcd < r ? xcd * (q + 1) : r * (q + 1) + (xcd - r) * q) + off; }
        const int nig = WGM * nN, gid = wgid / nig, fm = gid * WGM, gsz = (nM - fm) < WGM ? (nM - fm) : WGM;
        u.pm = fm + ((wgid % nig) % gsz); u.pn = (wgid % nig) / gsz; u.e = 0; u.rows = 256; u.base = 0; return true;
    }
    DEV unsigned a_off(const Unit& u, int h, int R, int Cb) const { return (unsigned)(((u.pm * BM + h * HALF + R) * lda + acol) * ELT + Cb); }
    DEV const char* b_ptr(const Unit& u) const { return Bt + (size_t)u.pn * BM * K * ELT; }
};
typedef DenseSchedT<false> DenseSched;
struct PoolSched {
    static constexpr bool BTILED = false;
    int G, c; const char* Bt;
    DEV bool next(int i, Unit& u) const { const int L = i * G + c; if (L >= 256) return false; u.pm = L >> 2; u.pn = 0; u.e = L & 3; u.rows = 256; u.base = 0; return true; }
    DEV unsigned a_off(const Unit& u, int h, int R, int Cb) const { return (unsigned)(((u.pm * BM + h * HALF + R) * 1024 + u.e * 256) * 2 + Cb); }
    DEV const char* b_ptr(const Unit& u) const { return Bt + (size_t)u.e * 256 * 256 * 2; }
};

DEV u32x4 pack8(const f32x4 a, const f32x4 b) { u32x4 w; w.x = cvt_pk_bf16(a[0], a[1]); w.y = cvt_pk_bf16(a[2], a[3]); w.z = cvt_pk_bf16(b[0], b[1]); w.w = cvt_pk_bf16(b[2], b[3]); return w; }
DEV void unpack8(const u32x4 w, f32x4& a, f32x4& b) { a[0] = __uint_as_float(w.x << 16); a[1] = __uint_as_float(w.x & 0xffff0000u); a[2] = __uint_as_float(w.y << 16); a[3] = __uint_as_float(w.y & 0xffff0000u);
    b[0] = __uint_as_float(w.z << 16); b[1] = __uint_as_float(w.z & 0xffff0000u); b[2] = __uint_as_float(w.w << 16); b[3] = __uint_as_float(w.w & 0xffff0000u); }
DEV float fsigm(float x) { return __builtin_amdgcn_rcpf(1.0f + __expf(-x)); }

DEV unsigned pk4_fp8(float a, float b, float c, float d) { int w = 0; w = __builtin_amdgcn_cvt_pk_fp8_f32(a, b, w, false); w = __builtin_amdgcn_cvt_pk_fp8_f32(c, d, w, true); return (unsigned)w; }
struct EpiProj { static constexpr bool PERM = true; bf16_t *u, *q, *k, *v, *sgp, *sga; int pn0;
    DEV void operator()(const f32x4 (&acc)[2][2][4][2], const Unit& un, int wr, int wc, int fr, int fq) const {
        const int pn = un.pn + pn0; bf16_t* base; int ldc, ct; bool sg = false;
        if (pn < 4) { base = u; ldc = 1024; ct = pn; } else if (pn < 12) { base = q; ldc = D; ct = pn - 4; } else if (pn < 20) { base = k; ldc = D; ct = pn - 12; }
        else if (pn < 28) { base = v; ldc = D; ct = pn - 20; } else if (pn < 36) { base = sgp; ldc = D; ct = pn - 28; sg = true; } else { base = sga; ldc = D; ct = pn - 36; sg = true; }
        const int row0 = un.pm * BM + wr * 64 + fr, col0 = ct * BM + wc * 32 + 8 * fq;
#pragma unroll
        for (int ai = 0; ai < 2; ++ai)
#pragma unroll
            for (int m = 0; m < 4; ++m) { bf16_t* rowp = base + (size_t)(row0 + ai * HALF + m * 16) * ldc + col0;
#pragma unroll
                for (int bj = 0; bj < 2; ++bj) { f32x4 v0 = acc[ai][bj][m][0], v1 = acc[ai][bj][m][1];
                    if (sg) {
#pragma unroll
                        for (int j = 0; j < 4; ++j) { v0[j] = fsigm(v0[j]); v1[j] = fsigm(v1[j]); } }
                    *(u32x4*)(rowp + bj * HALF) = pack8(v0, v1); } }
    } };
struct EpiSig8 { static constexpr bool PERM = true; bf16_t *sgp, *sga;
    DEV void operator()(const f32x4 (&acc)[2][2][4][2], const Unit& un, int wr, int wc, int fr, int fq) const {
        bf16_t* base = un.pn < 8 ? sgp : sga; const int ct = un.pn & 7;
        const int row0 = un.pm * BM + wr * 64 + fr, col0 = ct * BM + wc * 32 + 8 * fq;
#pragma unroll
        for (int ai = 0; ai < 2; ++ai)
#pragma unroll
            for (int m = 0; m < 4; ++m) { bf16_t* rowp = base + (size_t)(row0 + ai * HALF + m * 16) * D + col0;
#pragma unroll
                for (int bj = 0; bj < 2; ++bj) { f32x4 v0 = acc[ai][bj][m][0] * (1.0f / 64.0f), v1 = acc[ai][bj][m][1] * (1.0f / 64.0f);
#pragma unroll
                    for (int j = 0; j < 4; ++j) { v0[j] = fsigm(v0[j]); v1[j] = fsigm(v1[j]); }
                    *(u32x4*)(rowp + bj * HALF) = pack8(v0, v1); } }
    } };
struct EpiSigM { static constexpr bool PERM = true; bf16_t *u, *q, *k, *v, *sgp, *sga; const float* rope;
    DEV void operator()(const f32x4 (&acc)[2][2][4][2], const Unit& un, int wr, int wc, int fr, int fq) const {
        const int pn = un.pn; bf16_t* base; int ldc, ct; bool sg = false;
        if (pn < 4) { base = u; ldc = 1024; ct = pn; } else if (pn < 12) { base = q; ldc = D; ct = pn - 4; } else if (pn < 20) { base = k; ldc = D; ct = pn - 12; }
        else if (pn < 28) { base = v; ldc = D; ct = pn - 20; } else if (pn < 36) { base = sgp; ldc = D; ct = pn - 28; sg = true; } else { base = sga; ldc = D; ct = pn - 36; sg = true; }
        const int col0 = ct * BM + wc * 32 + 8 * fq;
        const bool rot = (pn >= 4 && pn < 20) && wc == 0;
#pragma unroll
        for (int ai = 0; ai < 2; ++ai)
#pragma unroll
            for (int m = 0; m < 4; ++m) { const int rl = ai * HALF + wr * 64 + m * 16 + fr; const int row = un.base + rl; bf16_t* rowp = base + (size_t)row * ldc + col0;
                f32x4 cs0, cs1, sn0, sn1;
                if (rot) { const float* rp = rope + (row % SEQ) * 16 + 8 * (fq & 1); cs0 = *(const f32x4*)rp; cs1 = *(const f32x4*)(rp + 4); sn0 = *(const f32x4*)(rp + SEQ * 16); sn1 = *(const f32x4*)(rp + SEQ * 16 + 4);
                    if (fq < 2) { sn0 = -sn0; sn1 = -sn1; } }
#pragma unroll
                for (int bj = 0; bj < 2; ++bj) { f32x4 v0 = acc[ai][bj][m][0] * (1.0f / 64.0f), v1 = acc[ai][bj][m][1] * (1.0f / 64.0f);
                    if (sg) {
#pragma unroll
                        for (int j = 0; j < 4; ++j) { v0[j] = fsigm(v0[j]); v1[j] = fsigm(v1[j]); } }
                    if (rot) { f32x4 p0, p1;
#pragma unroll
                        for (int j = 0; j < 4; ++j) { const unsigned a0 = __float_as_uint(v0[j]), a1 = __float_as_uint(v1[j]);
                            const auto r0 = __builtin_amdgcn_permlane32_swap(a0, a0, false, false); const auto r1 = __builtin_amdgcn_permlane32_swap(a1, a1, false, false);
                            p0[j] = __uint_as_float(fq < 2 ? r0[1] : r0[0]); p1[j] = __uint_as_float(fq < 2 ? r1[1] : r1[0]); }
                        v0 = v0 * cs0 + p0 * sn0; v1 = v1 * cs1 + p1 * sn1; }
                    if (rl < un.rows) *(u32x4*)(rowp + bj * HALF) = pack8(v0, v1); } }
    } };
struct EpiPool { static constexpr bool PERM = true; unsigned char* out; const float* scale;
    DEV void operator()(const f32x4 (&acc)[2][2][4][2], const Unit& un, int wr, int wc, int fr, int fq) const {
        const int row0 = un.pm * BM + wr * 64 + fr, col0 = un.e * 256 + wc * 32 + 8 * fq;
#pragma unroll
        for (int bj = 0; bj < 2; ++bj) { const f32x4 s0 = *(const f32x4*)(scale + col0 + bj * HALF), s1 = *(const f32x4*)(scale + col0 + bj * HALF + 4);
#pragma unroll
            for (int ai = 0; ai < 2; ++ai)
#pragma unroll
                for (int m = 0; m < 4; ++m) { const f32x4 v0 = acc[ai][bj][m][0] * s0, v1 = acc[ai][bj][m][1] * s1; u32x2 w; w.x = pk4_fp8(v0[0], v0[1], v0[2], v0[3]); w.y = pk4_fp8(v1[0], v1[1], v1[2], v1[3]);
                    *(u32x2*)(out + (size_t)(row0 + ai * HALF + m * 16) * 1024 + col0 + bj * HALF) = w; } }
    } };
template <int MODE> struct EpiGate { static constexpr bool PERM = true; bf16_t* out; const bf16_t* sg; const bf16_t* yp;
    DEV void operator()(const f32x4 (&acc)[2][2][4][2], const Unit& un, int wr, int wc, int fr, int fq) const {
        const int row0 = un.pm * BM + wr * 64 + fr, col0 = un.pn * BM + wc * 32 + 8 * fq;
#pragma unroll
        for (int ai = 0; ai < 2; ++ai)
#pragma unroll
            for (int m = 0; m < 4; ++m) { const size_t ro = (size_t)(row0 + ai * HALF + m * 16) * D + col0;
#pragma unroll
                for (int bj = 0; bj < 2; ++bj) { f32x4 g0, g1; unpack8(*(const u32x4*)(sg + ro + bj * HALF), g0, g1);
                    f32x4 v0 = g0 * acc[ai][bj][m][0], v1 = g1 * acc[ai][bj][m][1];
                    if (MODE == 1) { f32x4 y0, y1; unpack8(*(const u32x4*)(yp + ro + bj * HALF), y0, y1); v0 += y0; v1 += y1; }
                    *(u32x4*)(out + ro + bj * HALF) = pack8(v0, v1); } }
    } };
struct EpiGate8 { static constexpr bool PERM = true; unsigned char* out; const bf16_t* sg; const bf16_t* yp;
    DEV void operator()(const f32x4 (&acc)[2][2][4][2], const Unit& un, int wr, int wc, int fr, int fq) const {
        const int row0 = un.pm * BM + wr * 64 + fr, col0 = un.pn * BM + wc * 32 + 8 * fq;
#pragma unroll
        for (int ai = 0; ai < 2; ++ai)
#pragma unroll
            for (int m = 0; m < 4; ++m) { const size_t ro = (size_t)(row0 + ai * HALF + m * 16) * D + col0;
#pragma unroll
                for (int bj = 0; bj < 2; ++bj) { f32x4 g0, g1, y0, y1; unpack8(*(const u32x4*)(sg + ro + bj * HALF), g0, g1); unpack8(*(const u32x4*)(yp + ro + bj * HALF), y0, y1);
                    const f32x4 v0 = g0 * acc[ai][bj][m][0] + y0, v1 = g1 * acc[ai][bj][m][1] + y1;
                    u32x2 w; w.x = pk4_fp8(v0[0], v0[1], v0[2], v0[3]); w.y = pk4_fp8(v1[0], v1[1], v1[2], v1[3]); *(u32x2*)(out + ro + bj * HALF) = w; } }
    } };
template <int MODE> struct EpiGateM { static constexpr bool PERM = true; void* out; const bf16_t* sg; const bf16_t* yp;
    DEV void operator()(const f32x4 (&acc)[2][2][4][2], const Unit& un, int wr, int wc, int fr, int fq) const {
        const int col0 = un.pn * BM + wc * 32 + 8 * fq;
#pragma unroll
        for (int ai = 0; ai < 2; ++ai)
#pragma unroll
            for (int m = 0; m < 4; ++m) { const int rl = ai * HALF + wr * 64 + m * 16 + fr; const size_t ro = (size_t)(un.base + rl) * D + col0;
#pragma unroll
                for (int bj = 0; bj < 2; ++bj) { if (rl < un.rows) { f32x4 g0, g1; unpack8(*(const u32x4*)(sg + ro + bj * HALF), g0, g1);
                    f32x4 v0 = g0 * acc[ai][bj][m][0] * (1.0f / 64.0f), v1 = g1 * acc[ai][bj][m][1] * (1.0f / 64.0f);
                    if (MODE == 1) { f32x4 y0, y1; unpack8(*(const u32x4*)(yp + ro + bj * HALF), y0, y1); v0 += y0; v1 += y1;
                        u32x2 w; w.x = pk4_fp8(v0[0], v0[1], v0[2], v0[3]); w.y = pk4_fp8(v1[0], v1[1], v1[2], v1[3]); *(u32x2*)((unsigned char*)out + ro + bj * HALF) = w; }
                    else *(u32x4*)((bf16_t*)out + ro + bj * HALF) = pack8(v0, v1); } } }
    } };
struct EpiOutM { static constexpr bool PERM = true; bf16_t* x1; const float* x; const float* mod;
    DEV void operator()(const f32x4 (&acc)[2][2][4][2], const Unit& un, int wr, int wc, int fr, int fq) const {
        const int col0 = un.pn * BM + wc * 32 + 8 * fq;
        const float* g1 = mod + (un.base / SEQ) * 12288 + 2 * D;
#pragma unroll
        for (int bj = 0; bj < 2; ++bj) { const f32x4 g0 = *(const f32x4*)(g1 + col0 + bj * HALF) * (1.0f / 64.0f), g4 = *(const f32x4*)(g1 + col0 + bj * HALF + 4) * (1.0f / 64.0f);
#pragma unroll
            for (int ai = 0; ai < 2; ++ai)
#pragma unroll
                for (int m = 0; m < 4; ++m) { const int rl = ai * HALF + wr * 64 + m * 16 + fr; const size_t ro = (size_t)(un.base + rl) * D + col0 + bj * HALF;
                    if (rl < un.rows) *(u32x4*)(x1 + ro) = pack8(*(const f32x4*)(x + ro) + g0 * acc[ai][bj][m][0], *(const f32x4*)(x + ro + 4) + g4 * acc[ai][bj][m][1]); } }
    } };
struct EpiOut { static constexpr bool PERM = true; bf16_t* x1; const float* x; const float* mod;
    DEV void operator()(const f32x4 (&acc)[2][2][4][2], const Unit& un, int wr, int wc, int fr, int fq) const {
        const int row0 = un.pm * BM + wr * 64 + fr, col0 = un.pn * BM + wc * 32 + 8 * fq;
        const float* g1 = mod + ((un.pm * BM) / SEQ) * 12288 + 2 * D;
#pragma unroll
        for (int bj = 0; bj < 2; ++bj) { const f32x4 g0 = *(const f32x4*)(g1 + col0 + bj * HALF), g4 = *(const f32x4*)(g1 + col0 + bj * HALF + 4);
#pragma unroll
            for (int ai = 0; ai < 2; ++ai)
#pragma unroll
                for (int m = 0; m < 4; ++m) { const size_t ro = (size_t)(row0 + ai * HALF + m * 16) * D + col0 + bj * HALF;
                    *(u32x4*)(x1 + ro) = pack8(*(const f32x4*)(x + ro) + g0 * acc[ai][bj][m][0], *(const f32x4*)(x + ro + 4) + g4 * acc[ai][bj][m][1]); } }
    } };

template <bool DOWN, int NN = (DOWN ? 8 : 4), int AP = D, int BP = D> struct MoeSched {
    static constexpr bool BTILED = false;
    int G, c; const LAS int* tb; const int* list; const char* W;
    static constexpr int nN = NN;
    DEV bool next(int i, Unit& u) const {
        const int L = i * G + c; const int total = tb[TB_TSTART + 65] * nN; if (L >= total) return false;
        const int mtg = L / nN; u.pn = L % nN;
        const int lane = threadIdx.x & 63; const int ts = tb[TB_TSTART + lane], te = tb[TB_TSTART + lane + 1];
        const unsigned long long bal = __ballot(mtg >= ts && mtg < te);
        const int e = bal ? (int)__builtin_ctzll(bal) : NE;
        const int t0 = __builtin_amdgcn_readfirstlane(tb[TB_TSTART + e]); const int cnt = e < NE ? __builtin_amdgcn_readfirstlane(tb[TB_CNT + e]) : T;
        u.e = e; u.pm = mtg - t0; const int rem = cnt - u.pm * BM; u.rows = rem < BM ? rem : BM; u.base = __builtin_amdgcn_readfirstlane(tb[TB_ROWBASE + e]) + u.pm * BM; return true;
    }
    DEV unsigned a_off(const Unit& u, int h, int R, int Cb) const {
        const int rl = h * HALF + R;
        if (DOWN) return (unsigned)((u.base + rl) * ED + Cb);
        int tok;
        if (u.e < NE) tok = (rl < u.rows) ? (list[u.e * T + u.pm * BM + rl] >> 3) : 0; else tok = u.pm * BM + rl;
        return (unsigned)(tok * AP + Cb);
    }
    DEV const char* b_ptr(const Unit& u) const { return DOWN ? W + ((size_t)u.e * D + (size_t)u.pn * BM) * ED : W + ((size_t)u.e * 1024 + (size_t)u.pn * BM) * BP; }
};
constexpr float WSCALE = 64.0f, WINV = 1.0f / 64.0f;
struct EpiAct { static constexpr bool PERM = true; unsigned char* act;
    DEV void operator()(const f32x4 (&acc)[2][2][4][2], const Unit& un, int wr, int wc, int fr, int fq) const {
        const int col0 = un.pn * HALF + wc * 32 + 8 * fq;
#pragma unroll
        for (int ai = 0; ai < 2; ++ai)
#pragma unroll
            for (int m = 0; m < 4; ++m) { const int rl = ai * HALF + wr * 64 + m * 16 + fr;
                f32x4 v0, v1;
#pragma unroll
                for (int j = 0; j < 4; ++j) { const float g0 = acc[ai][0][m][0][j] * WINV, g1 = acc[ai][0][m][1][j] * WINV;
                    v0[j] = g0 * (acc[ai][1][m][0][j] * WINV) * __builtin_amdgcn_rcpf(1.0f + __expf(-g0)); v1[j] = g1 * (acc[ai][1][m][1][j] * WINV) * __builtin_amdgcn_rcpf(1.0f + __expf(-g1)); }
                if (rl < un.rows) { u32x2 w; w.x = pk4_fp8(v0[0], v0[1], v0[2], v0[3]); w.y = pk4_fp8(v1[0], v1[1], v1[2], v1[3]); *(u32x2*)(act + (size_t)(un.base + rl) * ED + col0) = w; } }
    } };
constexpr float YSCALE = 16.0f, YINV = 1.0f / 16.0f;
struct EpiDown { static constexpr bool PERM = true; unsigned char* yact;
    DEV void operator()(const f32x4 (&acc)[2][2][4][2], const Unit& un, int wr, int wc, int fr, int fq) const {
        const int col0 = un.pn * BM + wc * 64 + 16 * fq; constexpr float sc = WINV * YSCALE;
#pragma unroll
        for (int ai = 0; ai < 2; ++ai)
#pragma unroll
            for (int m = 0; m < 4; ++m) { const int rl = ai * HALF + wr * 64 + m * 16 + fr;
                if (rl < un.rows) { u32x4 w;
                    { const f32x4 v = acc[ai][0][m][0] * sc; w.x = pk4_fp8(v[0], v[1], v[2], v[3]); } { const f32x4 v = acc[ai][0][m][1] * sc; w.y = pk4_fp8(v[0], v[1], v[2], v[3]); }
                    { const f32x4 v = acc[ai][1][m][0] * sc; w.z = pk4_fp8(v[0], v[1], v[2], v[3]); } { const f32x4 v = acc[ai][1][m][1] * sc; w.w = pk4_fp8(v[0], v[1], v[2], v[3]); }
                    *(u32x4*)(yact + (size_t)(un.base + rl) * D + col0) = w; } }
    } };
}

DEV int perm32_inv(int c) { return ((c >> 2) & 1) * 16 + (((c >> 3) << 2) | (c & 3)); }
DEV void cvt_tile(const float* src, size_t ldS, bf16_t* dst, size_t ldD, int k0, int n0, int drow0, unsigned* buf  , int tiled = 0) {
    const int tid = threadIdx.x, n4 = tid & 15, kp = tid >> 4;
#pragma unroll
    for (int i = 0; i < 2; ++i) {
        const float* p = src + (size_t)(k0 + 2 * kp + 64 * i) * ldS + n0 + 4 * n4;
        const f32x4 a = *(const f32x4*)p, b = *(const f32x4*)(p + ldS);
#pragma unroll
        for (int j = 0; j < 4; ++j) buf[(4 * n4 + j) * 65 + kp + 32 * i] = mg::cvt_pk_bf16(a[j], b[j]);
    }
    __syncthreads();
    const int ch = tid & 15, nn = tid >> 4;
#pragma unroll
    for (int i = 0; i < 2; ++i) { const int n = nn + 32 * i; u32x4 w; w.x = buf[n * 65 + 4 * ch]; w.y = buf[n * 65 + 4 * ch + 1]; w.z = buf[n * 65 + 4 * ch + 2]; w.w = buf[n * 65 + 4 * ch + 3];
        if (tiled) { const int ng = drow0 + n, kg = k0 + 8 * ch, rb = ng & 127, R = tiled == 2 ? ((rb & ~31) + perm32_inv(rb & 31)) : rb;
            *(u32x4*)((char*)dst + ((size_t)((ng >> 8) * 2 + ((ng >> 7) & 1)) * (ldD >> 6) + (kg >> 6)) * mg::HTB + mg::lds_byte(R, kg & 63)) = w; }
        else *(u32x4*)(dst + (size_t)(drow0 + n) * ldD + k0 + 8 * ch) = w; }
    __syncthreads();
}
DEV void cvt_tile8(const float* src, size_t ldS, unsigned char* dst, size_t ldD, int k0, int n0, int drow0, unsigned* buf) {
    const int tid = threadIdx.x, n4 = tid & 15, kq = tid >> 4;
    const float* p = src + (size_t)(k0 + 4 * kq) * ldS + n0 + 4 * n4;
    const f32x4 a = *(const f32x4*)p * mg::WSCALE, b = *(const f32x4*)(p + ldS) * mg::WSCALE, c = *(const f32x4*)(p + 2 * ldS) * mg::WSCALE, d = *(const f32x4*)(p + 3 * ldS) * mg::WSCALE;
#pragma unroll
    for (int j = 0; j < 4; ++j) buf[(4 * n4 + j) * 33 + kq] = mg::pk4_fp8(a[j], b[j], c[j], d[j]);
    __syncthreads();
    const int ch = tid & 7, n = tid >> 3; u32x4 w; w.x = buf[n * 33 + 4 * ch]; w.y = buf[n * 33 + 4 * ch + 1]; w.z = buf[n * 33 + 4 * ch + 2]; w.w = buf[n * 33 + 4 * ch + 3];
    *(u32x4*)(dst + (size_t)(drow0 + n) * ldD + k0 + 16 * ch) = w;
    __syncthreads();
}
struct CvtTile { const float* src; unsigned char* dst; int ldS, ldD, perm; };
DEV CvtTile cvt_decode(int g, const float* wg, const float* wu, const float* wd, const float* sg, const float* su, const float* sd, char* wexp, size_t we_gu, size_t we_d) {
    const int e = g / 384, r = g % 384, mat = r >> 7, t = r & 127; CvtTile c;
    if (mat < 2) { const int kt = t >> 3, n0 = (t & 7) * 64; const float* base = mat == 0 ? (e < NE ? wg + (size_t)e * D * ED : sg) : (e < NE ? wu + (size_t)e * D * ED : su);
        c.src = base + (size_t)kt * 128 * ED + n0; c.ldS = ED; c.ldD = D; c.perm = 0;
        c.dst = (unsigned char*)(wexp + we_gu) + ((size_t)e * 1024 + 256 * (n0 >> 7) + (n0 & 127) + (mat == 1 ? 128 : 0)) * D + kt * 128; }
    else { const int kt = t >> 5, n0 = (t & 31) * 64; const float* base = e < NE ? wd + (size_t)e * ED * D : sd;
        c.src = base + (size_t)kt * 128 * D + n0; c.ldS = D; c.ldD = ED; c.perm = 1;
        c.dst = (unsigned char*)(wexp + we_d) + ((size_t)e * D + (n0 & ~255) + 32 * ((n0 & 255) >> 6)) * ED + kt * 128; }
    return c;
}
DEV void cvt_w8(const float* src, int ldS, int c0, int nct, int nkb, int ldD, unsigned char* dst, int gid, int gsz, unsigned* buf) {
    const int tid = threadIdx.x, n4 = tid & 15, kq = tid >> 4, ch = tid & 7, n = tid >> 3;
    for (int g0 = 4 * gid; g0 < nkb * nct; g0 += 4 * gsz) {
        f32x4 a[4], b[4], c[4], d[4];
#pragma unroll
        for (int q = 0; q < 4; ++q) { const int g = g0 + q, kt = g / nct, n0 = (g % nct) * 64; const float* p = src + (size_t)(kt * 128 + 4 * kq) * ldS + c0 + n0 + 4 * n4;
            a[q] = *(const f32x4*)p; b[q] = *(const f32x4*)(p + ldS); c[q] = *(const f32x4*)(p + 2 * ldS); d[q] = *(const f32x4*)(p + 3 * ldS); }
#pragma unroll
        for (int q = 0; q < 4; ++q)
#pragma unroll
            for (int j = 0; j < 4; ++j) buf[q * 2112 + (4 * n4 + j) * 33 + kq] = mg::pk4_fp8(a[q][j] * 64.0f, b[q][j] * 64.0f, c[q][j] * 64.0f, d[q][j] * 64.0f);
        __syncthreads();
#pragma unroll
        for (int q = 0; q < 4; ++q) { const int g = g0 + q, kt = g / nct, n0 = (g % nct) * 64; const unsigned* bq = buf + q * 2112 + n * 33 + 4 * ch; u32x4 w; w.x = bq[0]; w.y = bq[1]; w.z = bq[2]; w.w = bq[3];
            *(u32x4*)(dst + (size_t)(n0 + n) * ldD + kt * 128 + 16 * ch) = w; }
        __syncthreads();
    }
}
DEV void cvt_experts8(const float* wg, const float* wu, const float* wd, const float* sg, const float* su, const float* sd, char* wexp, size_t we_gu, size_t we_d, int gid, int gsz, unsigned* buf) {
    const int tid = threadIdx.x, n4 = tid & 15, kq = tid >> 4, ch = tid & 7, n = tid >> 3; constexpr int NT = 65 * 384;
    f32x4 a[4], b[4], c[4], d[4]; CvtTile ct[4];
    int g0 = 4 * gid;
#define CVT_LOAD(G) do { _Pragma("unroll") for (int q = 0; q < 4; ++q) { ct[q] = cvt_decode((G) + q, wg, wu, wd, sg, su, sd, wexp, we_gu, we_d); \
            const float* p = ct[q].src + (size_t)(4 * kq) * ct[q].ldS + 4 * n4; \
            a[q] = __builtin_nontemporal_load((const f32x4*)p); b[q] = __builtin_nontemporal_load((const f32x4*)(p + ct[q].ldS)); c[q] = __builtin_nontemporal_load((const f32x4*)(p + 2 * ct[q].ldS)); d[q] = __builtin_nontemporal_load((const f32x4*)(p + 3 * ct[q].ldS)); } } while (0)
    if (g0 < NT) CVT_LOAD(g0);
    for (; g0 < NT; g0 += 4 * gsz) {
        unsigned char* dstp[4]; int ldd[4], prm[4];
#pragma unroll
        for (int q = 0; q < 4; ++q) { dstp[q] = ct[q].dst; ldd[q] = ct[q].ldD; prm[q] = ct[q].perm; }
#pragma unroll
        for (int q = 0; q < 4; ++q)
#pragma unroll
            for (int j = 0; j < 4; ++j) buf[q * 2112 + (4 * n4 + j) * 33 + kq] = mg::pk4_fp8(a[q][j] * mg::WSCALE, b[q][j] * mg::WSCALE, c[q][j] * mg::WSCALE, d[q][j] * mg::WSCALE);
        if (g0 + 4 * gsz < NT) CVT_LOAD(g0 + 4 * gsz);
        asm volatile("s_waitcnt lgkmcnt(0)" ::: "memory"); __builtin_amdgcn_s_barrier(); asm volatile("" ::: "memory");
#pragma unroll
        for (int q = 0; q < 4; ++q) { const unsigned* bq = buf + q * 2112 + n * 33 + 4 * ch; u32x4 w; w.x = bq[0]; w.y = bq[1]; w.z = bq[2]; w.w = bq[3];
            const int rown = prm[q] ? (128 * ((n >> 3) & 1) + 8 * (n >> 4) + (n & 7)) : n;
            *(u32x4*)(dstp[q] + (size_t)rown * ldd[q] + 16 * ch) = w; }
        asm volatile("s_waitcnt lgkmcnt(0)" ::: "memory"); __builtin_amdgcn_s_barrier(); asm volatile("" ::: "memory");
    }
#undef CVT_LOAD
}
DEV void cvt_matrix(const float* src, int K, int N, bf16_t* dst, int& tbase, int first, int stride, unsigned* buf, int mode = 0, int tiled = 0) {
    const int nk = K / 128, nn = N / 64, ntile = nk * nn;
    int t = first - (tbase % stride); if (t < 0) t += stride;
    for (; t < ntile; t += stride) { const int kt = t / nn, ntl = t % nn, n0 = ntl * 64; const int dr = mode == 0 ? n0 : (256 * (n0 >> 7) + (n0 & 127) + (mode == 2 ? 128 : 0));
        cvt_tile(src, N, dst, K, kt * 128, n0, dr, buf, tiled); }
    tbase += ntile;
}

DEV void phase_rope(bf16_t* q, bf16_t* k, const float* rope, int gid, int gsz) {
    for (int it = gid * 512 + threadIdx.x; it < T * 32; it += gsz * 512) {
        const int ch = it & 15, which = (it >> 4) & 1, t = it >> 5, pos = t % SEQ;
        bf16_t* p = (which ? k : q) + (size_t)t * D + ch * 128;
        u32x4 a0 = *(const u32x4*)p, a1 = *(const u32x4*)(p + 8), b0 = *(const u32x4*)(p + 16), b1 = *(const u32x4*)(p + 24);
        f32x4 r1[4], r2[4]; mg::unpack8(a0, r1[0], r1[1]); mg::unpack8(a1, r1[2], r1[3]); mg::unpack8(b0, r2[0], r2[1]); mg::unpack8(b1, r2[2], r2[3]);
        const f32x4* cs = (const f32x4*)(rope + pos * 16); const f32x4* sn = (const f32x4*)(rope + SEQ * 16 + pos * 16);
        f32x4 o1[4], o2[4];
#pragma unroll
        for (int i = 0; i < 4; ++i) { const f32x4 c4 = cs[i], s4 = sn[i]; o1[i] = r1[i] * c4 - r2[i] * s4; o2[i] = r2[i] * c4 + r1[i] * s4; }
        *(u32x4*)p = mg::pack8(o1[0], o1[1]); *(u32x4*)(p + 8) = mg::pack8(o1[2], o1[3]); *(u32x4*)(p + 16) = mg::pack8(o2[0], o2[1]); *(u32x4*)(p + 24) = mg::pack8(o2[2], o2[3]);
    }
}
DEV void pool_pre_unit(const bf16_t* u, bf16_t* mixed, int pm, int e) {
    { const int it = (pm * 16 + ((int)threadIdx.x >> 5)) * 128 + 32 * e + ((int)threadIdx.x & 31);
        const int c8 = it & 127, t0 = (it >> 7) * 16, g = c8 >> 5, w = 2 << g, s0 = t0 % SEQ;
        const bf16_t* up = u + (size_t)t0 * 1024 + c8 * 8; bf16_t* mp = mixed + (size_t)t0 * 1024 + c8 * 8;
        f32x4 a0 = {0.f, 0.f, 0.f, 0.f}, a1 = a0, x0, x1;
#pragma unroll
        for (int j = 1; j < 16; ++j) if (j < w && s0 - j >= 0) { mg::unpack8(*(const u32x4*)(up - (ptrdiff_t)j * 1024), x0, x1); a0 += x0; a1 += x1; }
#pragma unroll
        for (int i = 0; i < 16; ++i) {
            mg::unpack8(*(const u32x4*)(up + (size_t)i * 1024), x0, x1); a0 += x0; a1 += x1;
            if (i >= 1 && s0 + i - w >= 0) { f32x4 y0, y1; mg::unpack8(*(const u32x4*)(up + (ptrdiff_t)(i - w) * 1024), y0, y1); a0 -= y0; a1 -= y1; }
            const int n = (s0 + i + 1) < w ? (s0 + i + 1) : w; const float inv = 1.0f / (float)n;
            *(u32x4*)(mp + (size_t)i * 1024) = mg::pack8(a0 * inv - x0, a1 * inv - x1);
        }
    }
}
DEV void phase_vt(const bf16_t* v, bf16_t* vt, unsigned* buf, int gid, int gsz) {
    const int tid = threadIdx.x;
    for (int tile = gid; tile < NBATCH * 8 * (SEQ / 64); tile += gsz) {
        const int kc = tile & 31, h = (tile >> 5) & 7, b = tile >> 8, k0 = kc * 64;
#pragma unroll
        for (int i = 0; i < 2; ++i) { const int cc = tid & 31, kp = (tid >> 5) + 16 * i;
            const bf16_t* p = v + (size_t)(b * SEQ + k0 + 2 * kp) * D + h * 256 + cc * 8;
            const u32x4 r0 = *(const u32x4*)p, r1 = *(const u32x4*)(p + D);
            const unsigned a[4] = {r0.x, r0.y, r0.z, r0.w}, c[4] = {r1.x, r1.y, r1.z, r1.w};
#pragma unroll
            for (int j = 0; j < 4; ++j) { buf[(8 * cc + 2 * j) * 33 + kp] = (a[j] & 0xffffu) | (c[j] << 16); buf[(8 * cc + 2 * j + 1) * 33 + kp] = (a[j] >> 16) | (c[j] & 0xffff0000u); }
        }
        __syncthreads();
#pragma unroll
        for (int i = 0; i < 4; ++i) { const int ch = tid & 7, c = (tid >> 3) + 64 * i; u32x4 w; w.x = buf[c * 33 + 4 * ch]; w.y = buf[c * 33 + 4 * ch + 1]; w.z = buf[c * 33 + 4 * ch + 2]; w.w = buf[c * 33 + 4 * ch + 3];
            *(u32x4*)(vt + ((size_t)(b * 8 + h) * 256 + c) * SEQ + k0 + 8 * ch) = w; }
        __syncthreads();
    }
}

namespace at {
constexpr int KB_ = 64 * 256, VB_ = 256 * 128, STG = 2 * KB_ + VB_;
struct TileOff { unsigned k0, k1, v0, v1; };
DEV TileOff tile_offsets(int wid, int lane) {
    TileOff t;
    { const int row = 8 * wid + (lane >> 4), ch = (lane & 15) ^ (row & 15); t.k0 = (unsigned)(row * D * 2 + ch * 16); }
    { const int row = 8 * wid + 4 + (lane >> 4), ch = (lane & 15) ^ (row & 15); t.k1 = (unsigned)(row * D * 2 + ch * 16); }
    { const int key = 8 * wid + (lane >> 5), c16 = (lane & 31) ^ ((key & 3) << 2); t.v0 = (unsigned)(key * D * 2 + c16 * 16); }
    { const int key = 8 * wid + 2 + (lane >> 5), c16 = (lane & 31) ^ ((key & 3) << 2); t.v1 = (unsigned)(key * D * 2 + c16 * 16); }
    return t;
}
DEV void issue_tile(LAS unsigned char* st, const char* kb, const char* vb, int key0, int wid, const TileOff& t) {
    const char* kt = kb + (size_t)key0 * D * 2; const char* vtp = vb + (size_t)key0 * D * 2;
    LAS unsigned char* kd = st + wid * 2048; LAS unsigned char* vd = st + 2 * KB_ + wid * 4096;
    __builtin_amdgcn_global_load_lds((const unsigned*)(kt + t.k0), (LAS unsigned*)(kd), 16, 0, 0);
    __builtin_amdgcn_global_load_lds((const unsigned*)(kt + t.k1), (LAS unsigned*)(kd + 1024), 16, 0, 0);
    __builtin_amdgcn_global_load_lds((const unsigned*)(kt + 256 + t.k0), (LAS unsigned*)(kd + KB_), 16, 0, 0);
    __builtin_amdgcn_global_load_lds((const unsigned*)(kt + 256 + t.k1), (LAS unsigned*)(kd + KB_ + 1024), 16, 0, 0);
    __builtin_amdgcn_global_load_lds((const unsigned*)(vtp + t.v0), (LAS unsigned*)(vd), 16, 0, 0);
    __builtin_amdgcn_global_load_lds((const unsigned*)(vtp + t.v1), (LAS unsigned*)(vd + 1024), 16, 0, 0);
    __builtin_amdgcn_global_load_lds((const unsigned*)(vtp + 4 * D * 2 + t.v0), (LAS unsigned*)(vd + 2048), 16, 0, 0);
    __builtin_amdgcn_global_load_lds((const unsigned*)(vtp + 4 * D * 2 + t.v1), (LAS unsigned*)(vd + 3072), 16, 0, 0);
}
struct SubBlk { int b, h, qblk; };
DEV int lane_id() { return (int)__builtin_amdgcn_mbcnt_hi(~0u, __builtin_amdgcn_mbcnt_lo(~0u, 0u)); }
DEV void load_q(bf16x8 (&qf)[8], const bf16_t* q, const SubBlk& sb, int wid) {
    int lane = lane_id(); asm volatile("" : "+v"(lane));
    const int c = wid >> 2, rg = wid & 3, l32 = lane & 31, hi = lane >> 5;
    const size_t tok = (size_t)sb.b * SEQ + sb.qblk * 128 + 32 * rg + l32;
#pragma unroll
    for (int d0 = 0; d0 < 8; ++d0) qf[d0] = *(const bf16x8*)(q + tok * D + sb.h * 256 + c * 128 + d0 * 16 + hi * 8);
}
DEV void attn_block(LAS unsigned char* lds, const bf16_t* q, const bf16_t* k, const bf16_t* vt, bf16_t* out, const SubBlk cur, const SubBlk nxt, const bool has_next, bf16x8 (&qf)[8], float lam, const float* subln_w, const int wid) {
    int lane = lane_id(); asm volatile("" : "+v"(lane));
    const int c = wid >> 2, rg = wid & 3, l32 = lane & 31, hi = lane >> 5;
    const int b = cur.b, h = cur.h, qblk = cur.qblk;
    const int q0w = qblk * 128 + 32 * rg, qpos = q0w + l32;
    f32x16 o[8]; float zero = 0.f; asm volatile("" : "+v"(zero));
#pragma unroll
    for (int cb = 0; cb < 8; ++cb)
#pragma unroll
        for (int r = 0; r < 16; ++r) o[cb][r] = zero;
    float m = -1e30f, lsum = 0.f;
    const int nt = 2 * qblk + 2;
    const char* kb = (const char*)(k + (size_t)b * SEQ * D + h * 256); const char* vb = (const char*)(vt + (size_t)b * SEQ * D + h * 256);
    const TileOff toff = tile_offsets(wid, lane);
    const int krow = ((l32 & ~0xC) | ((l32 & 4) << 1) | ((l32 & 8) >> 1)), kx = krow & 15;
    const unsigned kaddr = (unsigned)(c * KB_ + krow * 256 + (((hi ^ (kx & 1))) << 4) + ((kx >> 1) << 5));
    const int vq = (lane >> 2) & 3, vp = lane & 3;
    const unsigned vaddr = (unsigned)(2 * KB_ + hi * 4096 + vq * 512 + vq * 64 + ((lane >> 4) & 1) * 32 + (vp >> 1) * 16 + (vp & 1) * 8);
    constexpr float C2 = 0.08838834764831845f * 1.4426950408889634f;
    for (int j = 0; j < nt; ++j) {
        asm volatile("s_waitcnt vmcnt(0)" ::: "memory");
        __syncthreads();
        if (j + 1 < nt) issue_tile(lds + ((j + 1) & 1) * STG, kb, vb, (j + 1) * 64, wid, toff);
        else if (has_next) issue_tile(lds, (const char*)(k + (size_t)nxt.b * SEQ * D + nxt.h * 256), (const char*)(vt + (size_t)nxt.b * SEQ * D + nxt.h * 256), 0, wid, toff);
        const int k0 = j * 64;
        if (k0 <= q0w + 31) {
            LAS unsigned char* st = lds + (j & 1) * STG;
            f32x16 s0, s1;
#pragma unroll
            for (int r = 0; r < 16; ++r) { s0[r] = 0.f; s1[r] = 0.f; }
#define AT_SB() __builtin_amdgcn_sched_barrier(0)
#define AT_LDK(dst, dp) do { dst[0] = *(const LAS bf16x8*)(st + (kaddr ^ (unsigned)((2 * (dp)) << 5))); dst[1] = *(const LAS bf16x8*)(st + (kaddr ^ (unsigned)((2 * (dp)) << 5)) + 8192); \
                             dst[2] = *(const LAS bf16x8*)(st + (kaddr ^ (unsigned)((2 * (dp) + 1) << 5))); dst[3] = *(const LAS bf16x8*)(st + (kaddr ^ (unsigned)((2 * (dp) + 1) << 5)) + 8192); } while (0)
#define AT_MMK(src, dp) do { s0 = __builtin_amdgcn_mfma_f32_32x32x16_bf16(src[0], qf[2 * (dp)], s0, 0, 0, 0); s1 = __builtin_amdgcn_mfma_f32_32x32x16_bf16(src[1], qf[2 * (dp)], s1, 0, 0, 0); \
                             s0 = __builtin_amdgcn_mfma_f32_32x32x16_bf16(src[2], qf[2 * (dp) + 1], s0, 0, 0, 0); s1 = __builtin_amdgcn_mfma_f32_32x32x16_bf16(src[3], qf[2 * (dp) + 1], s1, 0, 0, 0); } while (0)
#define AT_LDV(dst, cb) do { dst[0] = *(const LAS bf16x8*)(st + vaddr + (cb) * 4096); dst[1] = *(const LAS bf16x8*)(st + (vaddr ^ 32u) + (cb) * 4096); \
                             dst[2] = *(const LAS bf16x8*)(st + (vaddr ^ 64u) + (cb) * 4096); dst[3] = *(const LAS bf16x8*)(st + (vaddr ^ 96u) + (cb) * 4096); } while (0)
#define AT_MMV(src, cb) do { o[cb] = __builtin_amdgcn_mfma_f32_32x32x16_bf16(src[0], pk[0], o[cb], 0, 0, 0); o[cb] = __builtin_amdgcn_mfma_f32_32x32x16_bf16(src[1], pk[1], o[cb], 0, 0, 0); \
                             o[cb] = __builtin_amdgcn_mfma_f32_32x32x16_bf16(src[2], pk[2], o[cb], 0, 0, 0); o[cb] = __builtin_amdgcn_mfma_f32_32x32x16_bf16(src[3], pk[3], o[cb], 0, 0, 0); } while (0)
            bf16x8 fa[2];
#define AT_LDK2(dst, d0) do { dst[0] = *(const LAS bf16x8*)(st + (kaddr ^ (unsigned)((d0) << 5))); dst[1] = *(const LAS bf16x8*)(st + (kaddr ^ (unsigned)((d0) << 5)) + 8192); } while (0)
#define AT_MMK2(src, d0) do { s0 = __builtin_amdgcn_mfma_f32_32x32x16_bf16(src[0], qf[d0], s0, 0, 0, 0); s1 = __builtin_amdgcn_mfma_f32_32x32x16_bf16(src[1], qf[d0], s1, 0, 0, 0); } while (0)
#pragma unroll
            for (int d0 = 0; d0 < 8; ++d0) { AT_LDK2(fa, d0); AT_MMK2(fa, d0); }
            AT_SB();
            if (k0 + 63 > q0w) {
                const float NEG = -__builtin_inff(); const int tq = k0 + 8 * hi - qpos;
#pragma unroll
                for (int r = 0; r < 16; ++r) { if (tq + (16 * (r >> 3) + (r & 7)) > 0) s0[r] = NEG; if (tq + (32 + 16 * (r >> 3) + (r & 7)) > 0) s1[r] = NEG; }
            }
            float mx = s0[0];
#pragma unroll
            for (int r = 1; r < 16; ++r) mx = fmaxf(mx, s0[r]);
#pragma unroll
            for (int r = 0; r < 16; ++r) mx = fmaxf(mx, s1[r]);
            mx = fmaxf(mx, __shfl_xor(mx, 32));
            float mn = m, alpha = 1.0f;
            const bool resc = !__all((mx - m) * C2 <= 8.0f);
            if (resc) { mn = fmaxf(m, mx); alpha = __builtin_amdgcn_exp2f((m - mn) * C2); m = mn; }
            const float mnl = -mn * C2;
            float ls = 0.f;
#pragma unroll
            for (int r = 0; r < 16; ++r) { s0[r] = __builtin_amdgcn_exp2f(fmaf(s0[r], C2, mnl)); s1[r] = __builtin_amdgcn_exp2f(fmaf(s1[r], C2, mnl)); ls += s0[r] + s1[r]; }
            lsum = lsum * alpha + ls;
            if (resc) {
#pragma unroll
                for (int cb = 0; cb < 8; ++cb)
#pragma unroll
                    for (int r = 0; r < 16; ++r) o[cb][r] *= alpha;
            }
            bf16x8 pk[4];
            { u32x4 w;
              w.x = mg::cvt_pk_bf16(s0[0], s0[1]); w.y = mg::cvt_pk_bf16(s0[2], s0[3]); w.z = mg::cvt_pk_bf16(s0[4], s0[5]); w.w = mg::cvt_pk_bf16(s0[6], s0[7]); pk[0] = *(bf16x8*)&w;
              w.x = mg::cvt_pk_bf16(s0[8], s0[9]); w.y = mg::cvt_pk_bf16(s0[10], s0[11]); w.z = mg::cvt_pk_bf16(s0[12], s0[13]); w.w = mg::cvt_pk_bf16(s0[14], s0[15]); pk[1] = *(bf16x8*)&w;
              w.x = mg::cvt_pk_bf16(s1[0], s1[1]); w.y = mg::cvt_pk_bf16(s1[2], s1[3]); w.z = mg::cvt_pk_bf16(s1[4], s1[5]); w.w = mg::cvt_pk_bf16(s1[6], s1[7]); pk[2] = *(bf16x8*)&w;
              w.x = mg::cvt_pk_bf16(s1[8], s1[9]); w.y = mg::cvt_pk_bf16(s1[10], s1[11]); w.z = mg::cvt_pk_bf16(s1[12], s1[13]); w.w = mg::cvt_pk_bf16(s1[14], s1[15]); pk[3] = *(bf16x8*)&w; }
#define AT_TR(dst, addr, off) asm volatile("ds_read_b64_tr_b16 %0, %1 offset:%2" : "=v"(dst) : "v"(addr), "i"(off))
#define AT_LDV2(dst, cb, hf) do { const unsigned va_ = stv + (vaddr ^ (unsigned)((cb) << 6)); u32x2 t0_, t1_, t2_, t3_; \
        AT_TR(t0_, va_, (2 * (hf)) * 8192); AT_TR(t1_, va_, (2 * (hf)) * 8192 + 2048); AT_TR(t2_, va_, (2 * (hf) + 1) * 8192); AT_TR(t3_, va_, (2 * (hf) + 1) * 8192 + 2048); \
        asm volatile("s_waitcnt lgkmcnt(0)" : "+v"(t0_), "+v"(t1_), "+v"(t2_), "+v"(t3_) :: "memory"); \
        { u32x4 w_; w_.x = t0_.x; w_.y = t0_.y; w_.z = t1_.x; w_.w = t1_.y; dst[0] = *(bf16x8*)&w_; w_.x = t2_.x; w_.y = t2_.y; w_.z = t3_.x; w_.w = t3_.y; dst[1] = *(bf16x8*)&w_; } } while (0)
#define AT_MMV2(src, cb, hf) do { o[cb] = __builtin_amdgcn_mfma_f32_32x32x16_bf16(src[0], pk[2 * (hf)], o[cb], 0, 0, 0); o[cb] = __builtin_amdgcn_mfma_f32_32x32x16_bf16(src[1], pk[2 * (hf) + 1], o[cb], 0, 0, 0); } while (0)
            AT_SB(); const unsigned stv = (unsigned)(unsigned long)st;
#pragma unroll
            for (int cb = 0; cb < 8; ++cb) { AT_LDV2(fa, cb, 0); AT_SB(); AT_MMV2(fa, cb, 0); AT_SB(); AT_LDV2(fa, cb, 1); AT_SB(); AT_MMV2(fa, cb, 1); AT_SB(); }
            AT_SB();
        }
    }
    lsum += __shfl_xor(lsum, 32);
    const float inv = 1.0f / lsum;
    if (has_next) load_q(qf, q, nxt, wid);
    __syncthreads();
    int lane2 = lane_id(); asm volatile("" : "+v"(lane2));
    const int hi2 = lane2 >> 5; const size_t tok2 = (size_t)b * SEQ + qblk * 128 + 32 * rg + (lane2 & 31);
    LAS unsigned* X = (LAS unsigned*)(lds + STG) + rg * 4096 + lane2;
    if (c == 1) {
#pragma unroll
        for (int cb = 0; cb < 8; ++cb)
#pragma unroll
            for (int r2 = 0; r2 < 8; ++r2) X[(cb * 8 + r2) * 64] = mg::cvt_pk_bf16(o[cb][2 * r2] * inv, o[cb][2 * r2 + 1] * inv);
    }
    __syncthreads();
    if (c == 0) {
        float ss = 0.f; const float lamv = *(const LAS float*)(lds + mg::STAGE_BYTES + 4800);
#pragma unroll
        for (int cb = 0; cb < 8; ++cb)
#pragma unroll
            for (int r2 = 0; r2 < 8; ++r2) { const unsigned w = X[(cb * 8 + r2) * 64];
                const float v0 = o[cb][2 * r2] * inv - lamv * __uint_as_float(w << 16), v1 = o[cb][2 * r2 + 1] * inv - lamv * __uint_as_float(w & 0xffff0000u);
                o[cb][2 * r2] = v0; o[cb][2 * r2 + 1] = v1; ss += v0 * v0 + v1 * v1; }
        ss += __shfl_xor(ss, 32);
        const float rn = rsqrtf(ss * (1.0f / 256.0f) + SUBLN_EPS) * (1.0f - LAMBDA_INIT);
        unsigned char* orow = (unsigned char*)out + tok2 * D + h * 256 + 4 * hi2; const LAS float* sw = (const LAS float*)(lds + mg::STAGE_BYTES + 6400) + 4 * hi2;
#pragma unroll
        for (int cb = 0; cb < 8; ++cb)
#pragma unroll
            for (int g = 0; g < 4; ++g) { const int col = 32 * cb + 8 * g; const f32x4 w = *(const LAS f32x4*)(sw + col);
                *(unsigned*)(orow + col) = mg::pk4_fp8(o[cb][4 * g] * rn * w[0], o[cb][4 * g + 1] * rn * w[1], o[cb][4 * g + 2] * rn * w[2], o[cb][4 * g + 3] * rn * w[3]); }
    }
}
DEV SubBlk sub_block(int sbi, int gid, int gsz) {
    const int cidx = gid + (sbi >> 1) * gsz, x = cidx & 7, y = (cidx >> 3) & 31, rnd = cidx >> 8, bh = rnd * 32 + x * 4 + (y >> 3), p = y & 7;
    SubBlk s; s.b = bh >> 3; s.h = bh & 7; s.qblk = (sbi & 1) ? 15 - p : p; return s;
}
DEV void attn_phase(LAS unsigned char* lds, const bf16_t* q, const bf16_t* k, const bf16_t* vt, bf16_t* out, const float* lq1, const float* lk1, const float* lq2, const float* lk2, const float* subln_w, int gid, int gsz) {
    const int lane = threadIdx.x & 63;
    float s1 = lq1[lane] * lk1[lane] + lq1[lane + 64] * lk1[lane + 64], s2 = lq2[lane] * lk2[lane] + lq2[lane + 64] * lk2[lane + 64];
    s1 = wave_sum(s1); s2 = wave_sum(s2);
    const float lam = expf(s1) - expf(s2) + LAMBDA_INIT;
    if (threadIdx.x == 0) *(LAS float*)(lds + mg::STAGE_BYTES + 4800) = lam;
    if (threadIdx.x < 64) ((LAS f32x4*)(lds + mg::STAGE_BYTES + 6400))[threadIdx.x] = ((const f32x4*)subln_w)[threadIdx.x];
    const int wid = __builtin_amdgcn_readfirstlane(threadIdx.x >> 6);
    const int nitem = gid < 512 ? (512 - gid + gsz - 1) / gsz : 0, nsb = 2 * nitem;
    if (nsb == 0) return;
    bf16x8 qf[8];
    { const SubBlk s0 = sub_block(0, gid, gsz); const TileOff toff = tile_offsets(wid, lane_id());
      __syncthreads();
      issue_tile(lds, (const char*)(k + (size_t)s0.b * SEQ * D + s0.h * 256), (const char*)(vt + (size_t)s0.b * SEQ * D + s0.h * 256), 0, wid, toff);
      load_q(qf, q, s0, wid); }
    for (int sbi = 0; sbi < nsb; ++sbi) {
        const SubBlk cur = sub_block(sbi, gid, gsz); const bool has_next = sbi + 1 < nsb; const SubBlk nxt = sub_block(has_next ? sbi + 1 : sbi, gid, gsz);
        attn_block(lds, q, k, vt, out, cur, nxt, has_next, qf, lam, subln_w, wid);
    }
    __syncthreads();
}
}


struct CvtTileB { const float* src; bf16_t* dst; int ldS, ldD, n0, k0, tiled; };
DEV CvtTileB cvt_decode_mix(int g, const float* w_in, const float* pool_w, const float* w_bp, const float* w_ba, const float* w_out, char* wmix, size_t o_in, size_t o_pool, size_t o_bp, size_t o_ba, size_t o_out) {
    CvtTileB c; int t, nn;
    { const int gg = g, grp = gg >> 3; t = gg & 7; nn = 4; c.src = pool_w + grp * 65536; c.dst = (bf16_t*)(wmix + o_pool) + grp * 65536; c.ldS = 256; c.ldD = 256; c.tiled = 0; }
    c.k0 = (t / nn) * 128; c.n0 = (t % nn) * 64; return c;
}
DEV void cvt_mix(const float* w_in, const float* pool_w, const float* w_bp, const float* w_ba, const float* w_out, char* wmix, size_t o_in, size_t o_pool, size_t o_bp, size_t o_ba, size_t o_out, int gid, int gsz, unsigned* buf) {
    const int tid = threadIdx.x, n4 = tid & 15, kp = tid >> 4, ch = tid & 15, nn = tid >> 4; constexpr int NT = 32;
    for (int g0 = 4 * gid; g0 < NT; g0 += 4 * gsz) {
        f32x4 a[4][2], b[4][2]; CvtTileB ct[4];
#pragma unroll
        for (int q = 0; q < 4; ++q) { ct[q] = cvt_decode_mix(g0 + q, w_in, pool_w, w_bp, w_ba, w_out, wmix, o_in, o_pool, o_bp, o_ba, o_out);
#pragma unroll
            for (int i = 0; i < 2; ++i) { const float* p = ct[q].src + (size_t)(ct[q].k0 + 2 * kp + 64 * i) * ct[q].ldS + ct[q].n0 + 4 * n4; a[q][i] = *(const f32x4*)p; b[q][i] = *(const f32x4*)(p + ct[q].ldS); } }
#pragma unroll
        for (int q = 0; q < 4; ++q)
#pragma unroll
            for (int i = 0; i < 2; ++i)
#pragma unroll
                for (int j = 0; j < 4; ++j) buf[q * 4160 + (4 * n4 + j) * 65 + kp + 32 * i] = mg::cvt_pk_bf16(a[q][i][j], b[q][i][j]);
        __syncthreads();
#pragma unroll
        for (int q = 0; q < 4; ++q)
#pragma unroll
            for (int i = 0; i < 2; ++i) { const int n = nn + 32 * i; const unsigned* bq = buf + q * 4160 + n * 65 + 4 * ch; u32x4 w; w.x = bq[0]; w.y = bq[1]; w.z = bq[2]; w.w = bq[3];
                const int ng = ct[q].n0 + n, kg = ct[q].k0 + 8 * ch;
                if (ct[q].tiled) { const int rb = ng & 127, R = (rb & ~31) + perm32_inv(rb & 31);
                    *(u32x4*)((char*)ct[q].dst + ((size_t)((ng >> 8) * 2 + ((ng >> 7) & 1)) * (ct[q].ldD >> 6) + (kg >> 6)) * mg::HTB + mg::lds_byte(R, kg & 63)) = w; }
                else *(u32x4*)(ct[q].dst + (size_t)ng * ct[q].ldD + kg) = w; }
        __syncthreads();
    }
}
constexpr size_t WM_IN = 0, WM_POOL = (size_t)INW * D * 2, WM_BP = WM_POOL + 4 * 256 * 256 * 2, WM_BA = WM_BP + (size_t)D * 1024 * 2, WM_OUT = WM_BA + (size_t)D * D * 2;
constexpr size_t WE_GU = 0, WE_D = (size_t)65 * 1024 * D;
#define XB_TMO      128
#define XB_XCNT(j)  (256  + 64 * (j))
#define XB_XSUB(j)  (1280 + 64 * (j))
#define XB_XGEN(j)  (2304 + 64 * (j))
#define XB_TOP      3328
#define XB_TOPGEN   3392
#define XCD_BAR_WORDS 3456
#define XB_SPIN_CAP (1u << 18)

__device__ __forceinline__ unsigned xb_ld(unsigned* p)              { return __hip_atomic_load(p, __ATOMIC_RELAXED, __HIP_MEMORY_SCOPE_AGENT); }
__device__ __forceinline__ unsigned xb_add(unsigned* p, unsigned v) { return __hip_atomic_fetch_add(p, v, __ATOMIC_RELAXED, __HIP_MEMORY_SCOPE_AGENT); }
__device__ __forceinline__ unsigned xb_xcc_id() { return (unsigned)__builtin_amdgcn_s_getreg((3 << 11) | 20) & 0xFu; }
#define XB_SPIN(cond, bar) do { unsigned _sp = 0; while (cond) { __builtin_amdgcn_s_sleep(1); \
    if ((++_sp & 255u) == 0u) { if (xb_ld(&(bar)[XB_TMO])) break; if (_sp > XB_SPIN_CAP) { atomicAdd(&(bar)[XB_TMO], 1u); break; } } } } while (0)

struct XcdBarrier {
    unsigned* bar; unsigned x;
    volatile LAS unsigned* st;
};

__device__ __forceinline__ XcdBarrier xcd_barrier_post(unsigned* bar, volatile LAS unsigned* st) {
    XcdBarrier b; b.bar = bar; b.x = xb_xcc_id(); b.st = st;
    if (threadIdx.x == 0) (void)xb_add(&bar[XB_XCNT(b.x)], 1u);
    return b;
}
__device__ __forceinline__ void xcd_barrier_complete(unsigned* bar, unsigned x, unsigned& nloc, unsigned& nx) {
    const unsigned G = gridDim.x * gridDim.y * gridDim.z;
    unsigned sum, cnt, mine, sp = 0u;
    for (;;) {
        sum = 0u; cnt = 0u; mine = 0u;
#pragma unroll
        for (unsigned j = 0; j < 16; ++j) { const unsigned c = xb_ld(&bar[XB_XCNT(j)]); sum += c; cnt += (c > 0u) ? 1u : 0u; mine = (j == x) ? c : mine; }
        if (sum == G) break;
        __builtin_amdgcn_s_sleep(1);
        if ((++sp & 255u) == 0u) { if (xb_ld(&bar[XB_TMO])) break; if (sp > XB_SPIN_CAP) { atomicAdd(&bar[XB_TMO], 1u); break; } }
    }
    nloc = mine > 0u ? mine : 1u; nx = cnt > 0u ? cnt : 1u;
}

__device__ __forceinline__ void xcd_barrier(const XcdBarrier& b) {
    asm volatile("s_waitcnt vmcnt(0)" ::: "memory");
    __syncthreads();
    if (threadIdx.x == 0) {
        unsigned* bar = b.bar;
        __builtin_amdgcn_s_waitcnt(0);
        unsigned nloc = b.st[0], nx = b.st[1];
        if (nloc == 0u) { xcd_barrier_complete(bar, b.x, nloc, nx); b.st[0] = nloc; b.st[1] = nx; }
        const unsigned old = xb_add(&bar[XB_XSUB(b.x)], 1u);
        const unsigned gen = old / nloc;
        if (old + 1u == (gen + 1u) * nloc) {
            __builtin_amdgcn_fence(__ATOMIC_RELEASE, "agent");
            asm volatile("s_waitcnt vmcnt(0)" ::: "memory");
            const unsigned og = xb_add(&bar[XB_TOP], 1u);
            const unsigned tg = og / nx;
            if (og + 1u == (tg + 1u) * nx) xb_add(&bar[XB_TOPGEN], 1u);
            else XB_SPIN(xb_ld(&bar[XB_TOPGEN]) == tg, bar);
            __builtin_amdgcn_fence(__ATOMIC_ACQUIRE, "agent");
            xb_add(&bar[XB_XGEN(b.x)], 1u);
            asm volatile("s_waitcnt vmcnt(0)" ::: "memory");
        } else {
            XB_SPIN(xb_ld(&bar[XB_XGEN(b.x)]) == gen, bar);
            __builtin_amdgcn_fence(__ATOMIC_ACQUIRE, "agent");
            asm volatile("s_waitcnt vmcnt(0)" ::: "memory");
        }
    }
    __syncthreads();
}


DEV void phase_norm_mod(const float* x, const float* w, const float* mod, bf16_t* h, unsigned char* h8, int gid, int gsz) {
    const int wid = threadIdx.x >> 6, lane = threadIdx.x & 63;
    for (int row = gid * 8 + wid; row < T; row += gsz * 8) {
        const int b = row / SEQ; const f32x4* xr = (const f32x4*)(x + (size_t)row * D);
        f32x4 v[8]; float ss = 0.f;
#pragma unroll
        for (int i = 0; i < 8; ++i) { v[i] = xr[lane + 64 * i]; ss += v[i][0] * v[i][0] + v[i][1] * v[i][1] + v[i][2] * v[i][2] + v[i][3] * v[i][3]; }
        ss = wave_sum(ss); const float r = rsqrtf(ss * (1.0f / D) + NORM_EPS);
        const f32x4* wv = (const f32x4*)w; const f32x4* sh = (const f32x4*)(mod + b * 12288); const f32x4* sc = (const f32x4*)(mod + b * 12288 + D);
#pragma unroll
        for (int i = 0; i < 8; ++i) { const int j = lane + 64 * i; const f32x4 o = v[i] * r * wv[j] * (sc[j] + 1.0f) + sh[j];
            *(unsigned*)(h8 + (size_t)row * D + 4 * j) = mg::pk4_fp8(o[0], o[1], o[2], o[3]); }
    }
}
DEV void phase_ada_rope(LAS unsigned char* lds, const float* c, const float* w_ada, const float* b_ada, float* mod, float* rope, int gid) {
    const int tid = threadIdx.x;
    if (gid < 192) {
        LAS float* cs = (LAS float*)lds; LAS float* red = (LAS float*)(lds + 65536);
        for (int i = tid; i < NBATCH * D; i += 512) { const float cv = c[i]; cs[i] = cv / (1.0f + expf(-cv)); }
        __syncthreads();
        const int cg = tid & 15, kr = tid >> 4; f32x4 acc[8];
#pragma unroll
        for (int b = 0; b < 8; ++b) acc[b] = (f32x4){0.f, 0.f, 0.f, 0.f};
        const float* wp = w_ada + (size_t)kr * 12288 + gid * 64 + cg * 4;
#pragma unroll 1
        for (int i0 = 0; i0 < 64; i0 += 8) { f32x4 w4[8];
#pragma unroll
            for (int u = 0; u < 8; ++u) w4[u] = *(const f32x4*)(wp + (size_t)(i0 + u) * 32 * 12288);
#pragma unroll
            for (int u = 0; u < 8; ++u) { const int k = kr + 32 * (i0 + u);
#pragma unroll
                for (int b = 0; b < 8; ++b) acc[b] += w4[u] * cs[b * D + k]; } }
#pragma unroll
        for (int b = 0; b < 8; ++b) *(LAS f32x4*)(red + (kr * 8 + b) * 64 + cg * 4) = acc[b];
        __syncthreads();
        { const int b = tid >> 6, col = tid & 63; float sum = 0.f; for (int k2 = 0; k2 < 32; ++k2) sum += red[(k2 * 8 + b) * 64 + col];
          mod[b * 12288 + gid * 64 + col] = sum + b_ada[gid * 64 + col]; }
        __syncthreads();
    } else {
        const int i = (gid - 192) * 512 + tid; if (i < SEQ * 16) { const int pos = i >> 4, f = i & 15;
            const double inv = exp2(-(double)f * (18.931568569324174 / 16.0));
            const double ang = (double)pos * inv; const double n = rint(ang * 0.15915494309189535); const float r = (float)fma(-n, 6.283185307179586, ang);
            rope[i] = cosf(r); rope[SEQ * 16 + i] = sinf(r); }
    }
}
DEV void phase_router(LAS unsigned char* lds, LAS int* tbl, const bf16_t* x1, const float* norm2_w, const float* mod, const bf16_t* wrt, const float* router_bias,
                      unsigned char* h2, int* eidx, float* gate, int* ctrl, int* list, int* posin, int gid, int gsz) {
    const int tid = threadIdx.x, wid = tid >> 6, lane = tid & 63;
    LAS int* hist = tbl + 512; LAS int* basev = tbl + 576; LAS int* lpos = tbl + 640;
    LAS float* rstd = (LAS float*)lds;
    LAS float* lg = (LAS float*)(lds + 1024);
    for (int grp = gid; grp < T / 64; grp += gsz) {
        const int t0 = grp * 64, b = t0 / SEQ;
        if (tid < 64) hist[tid] = 0;
        { LAS f32x4* gl = (LAS f32x4*)(lds + 49152); LAS f32x4* sl = (LAS f32x4*)(lds + 57344);
          const f32x4 g4 = ((const f32x4*)norm2_w)[tid] * (((const f32x4*)(mod + b * 12288 + 4 * D))[tid] + 1.0f); gl[tid] = g4; sl[tid] = ((const f32x4*)(mod + b * 12288 + 3 * D))[tid]; }
        for (int r = 0; r < 8; r += 2) { const int t = t0 + wid * 8 + r; const u32x4* xr = (const u32x4*)(x1 + (size_t)t * D); float ssa = 0.f, ssb = 0.f; u32x4 va[4], vb[4];
#pragma unroll
            for (int i = 0; i < 4; ++i) { va[i] = xr[lane + 64 * i]; vb[i] = xr[D / 8 + lane + 64 * i]; }
#pragma unroll
            for (int i = 0; i < 4; ++i) { f32x4 a0, a1, b0, b1; mg::unpack8(va[i], a0, a1); mg::unpack8(vb[i], b0, b1);
                ssa += a0[0] * a0[0] + a0[1] * a0[1] + a0[2] * a0[2] + a0[3] * a0[3] + a1[0] * a1[0] + a1[1] * a1[1] + a1[2] * a1[2] + a1[3] * a1[3];
                ssb += b0[0] * b0[0] + b0[1] * b0[1] + b0[2] * b0[2] + b0[3] * b0[3] + b1[0] * b1[0] + b1[1] * b1[1] + b1[2] * b1[2] + b1[3] * b1[3]; }
            ssa = wave_sum(ssa); ssb = wave_sum(ssb);
            if (lane == 0) { rstd[wid * 8 + r] = rsqrtf(ssa * (1.0f / D) + NORM_EPS); rstd[wid * 8 + r + 1] = rsqrtf(ssb * (1.0f / D) + NORM_EPS); } }
        __syncthreads();
        { const int mb = wid & 1, nb = (wid >> 1) & 1, kh = wid >> 2, l32 = lane & 31, kg = lane >> 5;
          const int t = t0 + 32 * mb + l32; const float rs = rstd[32 * mb + l32];
          const bf16_t* xr = x1 + (size_t)t * D + kh * 1024 + 16 * kg;
          const LAS float* gl = (const LAS float*)(lds + 49152) + kh * 1024 + 16 * kg; const LAS float* sl = (const LAS float*)(lds + 57344) + kh * 1024 + 16 * kg;
          const bf16_t* bh = wrt + (size_t)(32 * nb + l32) * D + kh * 1024 + 16 * kg; const bf16_t* bl = bh + NE * D;
          unsigned char* hrow = h2 + (size_t)t * D + kh * 1024 + 16 * kg;
          f32x16 acc;
#pragma unroll
          for (int r = 0; r < 16; ++r) acc[r] = 0.f;
#define RT_LOAD(X, B, kp_) do { const int ko_ = (kp_) * 32; mg::unpack8(*(const u32x4*)(xr + ko_), X[0], X[1]); mg::unpack8(*(const u32x4*)(xr + ko_ + 8), X[2], X[3]); \
              B[0] = *(const bf16x8*)(bh + ko_); B[1] = *(const bf16x8*)(bh + ko_ + 8); B[2] = *(const bf16x8*)(bl + ko_); B[3] = *(const bf16x8*)(bl + ko_ + 8); } while (0)
#define RT_STEP(X, B, kp_) do { const int ko_ = (kp_) * 32; f32x4 h[4]; \
              _Pragma("unroll") for (int q = 0; q < 4; ++q) h[q] = X[q] * rs * *(const LAS f32x4*)(gl + ko_ + 4 * q) + *(const LAS f32x4*)(sl + ko_ + 4 * q); \
              if (nb == 0) { u32x4 w16; w16.x = mg::pk4_fp8(h[0][0], h[0][1], h[0][2], h[0][3]); w16.y = mg::pk4_fp8(h[1][0], h[1][1], h[1][2], h[1][3]); \
                  w16.z = mg::pk4_fp8(h[2][0], h[2][1], h[2][2], h[2][3]); w16.w = mg::pk4_fp8(h[3][0], h[3][1], h[3][2], h[3][3]); *(u32x4*)(hrow + ko_) = w16; } \
              _Pragma("unroll") for (int hf = 0; hf < 2; ++hf) { u32x4 hi4 = mg::pack8(h[2 * hf], h[2 * hf + 1]); f32x4 e0, e1; mg::unpack8(hi4, e0, e1); \
                  const u32x4 lo4 = mg::pack8(h[2 * hf] - e0, h[2 * hf + 1] - e1); const bf16x8 ahi = *(const bf16x8*)&hi4, alo = *(const bf16x8*)&lo4; \
                  acc = __builtin_amdgcn_mfma_f32_32x32x16_bf16(ahi, B[hf], acc, 0, 0, 0); acc = __builtin_amdgcn_mfma_f32_32x32x16_bf16(alo, B[hf], acc, 0, 0, 0); \
                  acc = __builtin_amdgcn_mfma_f32_32x32x16_bf16(ahi, B[2 + hf], acc, 0, 0, 0); } } while (0)
          f32x4 xa[4], xb[4]; bf16x8 ba[4], bb[4];
          RT_LOAD(xa, ba, 0);
#pragma unroll 1
          for (int kp = 0; kp < 32; kp += 2) {
              RT_LOAD(xb, bb, kp + 1); __builtin_amdgcn_sched_barrier(0);
              RT_STEP(xa, ba, kp); __builtin_amdgcn_sched_barrier(0);
              RT_LOAD(xa, ba, (kp + 2 < 32 ? kp + 2 : kp)); __builtin_amdgcn_sched_barrier(0);
              RT_STEP(xb, bb, kp + 1); __builtin_amdgcn_sched_barrier(0);
          }
#undef RT_LOAD
#undef RT_STEP
#pragma unroll
          for (int r = 0; r < 16; ++r) lg[(kh * 64 + 32 * mb + (r & 3) + 8 * (r >> 2) + 4 * kg) * 64 + 32 * nb + l32] = acc[r];
        }
        __syncthreads();
        const float rbias = router_bias[lane];
        LAS float* wv = (LAS float*)(lds + 40960) + wid * 128;
        for (int r = 0; r < 8; ++r) {
            const int tl = wid * 8 + r, t = t0 + tl; const float logit = lg[tl * 64 + lane] + lg[(64 + tl) * 64 + lane];
            const float score = sigm(logit), biased = score + rbias;
            float m1 = biased; for (int o = 1; o < 8; o <<= 1) m1 = fmaxf(m1, __shfl_xor(m1, o));
            int i1 = (biased == m1) ? lane : 64; for (int o = 1; o < 8; o <<= 1) { const int xx = __shfl_xor(i1, o); i1 = xx < i1 ? xx : i1; }
            float m2 = (lane == i1) ? -INFINITY : biased; for (int o = 1; o < 8; o <<= 1) m2 = fmaxf(m2, __shfl_xor(m2, o));
            const float gs = m1 + m2; const int myg = lane >> 3;
            if ((lane & 7) == 0) wv[64 + myg] = gs;
            int grank = 0;
            { const f32x4 ga = *(const LAS f32x4*)(wv + 64), gb = *(const LAS f32x4*)(wv + 68);
#pragma unroll
              for (int g = 0; g < 4; ++g) { grank += (ga[g] > gs || (ga[g] == gs && g < myg)) ? 1 : 0; grank += (gb[g] > gs || (gb[g] == gs && g + 4 < myg)) ? 1 : 0; } }
            const bool gsel = grank < 4; const float mv = gsel ? biased : -INFINITY;
            wv[lane] = mv;
            int rk = 0; int lane_t = lane; asm volatile("" : "+v"(lane_t));
#pragma unroll
            for (int q = 0; q < 16; ++q) { const f32x4 v4 = *(const LAS f32x4*)(wv + 4 * q);
#pragma unroll
                for (int j = 0; j < 4; ++j) rk += (v4[j] > mv || (v4[j] == mv && 4 * q + j < lane_t)) ? 1 : 0; }
            const bool chosen = gsel && rk < TOPK; const float ssum = wave_sum(chosen ? score : 0.f);
            if (chosen) { eidx[t * 8 + rk] = lane; gate[t * 8 + rk] = score / ssum * 2.5f; lpos[tl * 8 + rk] = (lane << 16) | __hip_atomic_fetch_add(hist + lane, 1, __ATOMIC_RELAXED, __HIP_MEMORY_SCOPE_WORKGROUP); }
        }
        __syncthreads();
        if (tid < 64) basev[tid] = atomicAdd(&ctrl[C_CNT + tid], hist[tid]);
        __syncthreads();
        { const int v = lpos[tid], e = v >> 16, lp = v & 0xffff, slot = (t0 + (tid >> 3)) * 8 + (tid & 7); list[e * T + basev[e] + lp] = slot; posin[slot] = basev[e] + lp; }
        __syncthreads();
    }
}
DEV void moe_tables(LAS int* tbl, const int* ctrl) {
    __syncthreads();
    if (threadIdx.x < 64) tbl[TB_CNT + threadIdx.x] = ctrl[C_CNT + threadIdx.x];
    __syncthreads();
    if (threadIdx.x == 0) { int sr = 0, ts = 0; for (int e = 0; e < NE; ++e) { const int cn = tbl[TB_CNT + e]; tbl[TB_ROWBASE + e] = sr; tbl[TB_TSTART + e] = ts; sr += cn; ts += (cn + 255) >> 8; }
        tbl[TB_ROWBASE + NE] = sr; tbl[TB_TSTART + NE] = ts; tbl[TB_TSTART + NE + 1] = ts + T / 256; }
    __syncthreads();
}
DEV void phase_final(float* out, const bf16_t* x1, const unsigned char* yact, const int* eidx, const int* posin, const float* gate, LAS int* tbl, const float* mod, const float* fw, int gid, int gsz) {
    const int wid = threadIdx.x >> 6, lane = threadIdx.x & 63;
    for (int row = gid * 8 + wid; row < T; row += gsz * 8) {
        const int b = row / SEQ; float* xr = out + (size_t)row * D; const float* g2 = mod + b * 12288 + 5 * D;
        int myrow = 0; float myg = 0.f;
        if (lane < 8) { const int sl = row * 8 + lane; myrow = tbl[TB_ROWBASE + eidx[sl]] + posin[sl]; myg = gate[sl]; }
        else if (lane == 8) { myrow = tbl[TB_ROWBASE + NE] + row; myg = 1.0f; }
        f32x4 v[2][4]; float ss = 0.f;
#pragma unroll
        for (int i = 0; i < 2; ++i)
#pragma unroll
            for (int q = 0; q < 4; ++q) v[i][q] = (f32x4){0.f, 0.f, 0.f, 0.f};
#pragma unroll 1
        for (int kh = 0; kh < 3; ++kh) {
            u32x4 y[3][2]; float gk[3];
#pragma unroll
            for (int k = 0; k < 3; ++k) { const int rk = __shfl(myrow, kh * 3 + k); gk[k] = __shfl(myg, kh * 3 + k); const unsigned char* yb = yact + (size_t)rk * D + 16 * lane;
#pragma unroll
                for (int i = 0; i < 2; ++i) y[k][i] = *(const u32x4*)(yb + 1024 * i); }
#pragma unroll
            for (int k = 0; k < 3; ++k)
#pragma unroll
                for (int i = 0; i < 2; ++i) {
#pragma unroll
                    for (int q = 0; q < 4; ++q) { const int w = (int)y[k][i][q]; const auto lo = __builtin_amdgcn_cvt_pk_f32_fp8(w, false), hi = __builtin_amdgcn_cvt_pk_f32_fp8(w, true);
                        v[i][q][0] += gk[k] * lo[0]; v[i][q][1] += gk[k] * lo[1]; v[i][q][2] += gk[k] * hi[0]; v[i][q][3] += gk[k] * hi[1]; } }
        }
#pragma unroll
        for (int i = 0; i < 2; ++i)
#pragma unroll
            for (int q = 0; q < 4; ++q) { const int c0 = 16 * (lane + 64 * i) + 4 * q; const u32x2 xw = *(const u32x2*)(x1 + (size_t)row * D + c0);
                const f32x4 xv = {__uint_as_float(xw.x << 16), __uint_as_float(xw.x & 0xffff0000u), __uint_as_float(xw.y << 16), __uint_as_float(xw.y & 0xffff0000u)};
                v[i][q] = xv + *(const f32x4*)(g2 + c0) * (v[i][q] * mg::YINV);
                ss += v[i][q][0] * v[i][q][0] + v[i][q][1] * v[i][q][1] + v[i][q][2] * v[i][q][2] + v[i][q][3] * v[i][q][3]; }
        ss = wave_sum(ss); const float rn = rsqrtf(ss * (1.0f / D) + NORM_EPS);
#pragma unroll
        for (int i = 0; i < 2; ++i)
#pragma unroll
            for (int q = 0; q < 4; ++q) { const int c0 = 16 * (lane + 64 * i) + 4 * q; *(f32x4*)(xr + c0) = v[i][q] * rn * *(const f32x4*)(fw + c0); }
    }
}

struct Params {
    const float *x, *c, *w_ada, *b_ada, *norm1_w, *w_in, *pool_w, *pool_scale, *w_bp, *lq1, *lk1, *lq2, *lk2, *subln_w, *w_ba, *w_out, *norm2_w, *w_router, *router_bias,
                *wg, *wu, *wd, *sg, *su, *sd, *final_w;
    float* out; char* ws; int p_lo, p_hi;
};
constexpr int LDS_TBL = mg::STAGE_BYTES, LDS_TOTAL = mg::STAGE_BYTES + 8192;
#define PHASE(i) if (P.p_lo <= (i) && (i) < P.p_hi)
#define SEAM(i) if (P.p_lo <= (i) && (i) + 1 < P.p_hi) xcd_barrier(bar)
constexpr int NGEMM = 188;
__global__ __launch_bounds__(512, 2) void fwd(const Params P) {
    extern __shared__ __attribute__((aligned(16))) unsigned char shm[];
    LAS unsigned char* lds = (LAS unsigned char*)shm; LAS int* tbl = (LAS int*)(lds + LDS_TBL);
    volatile LAS unsigned* xbw = (volatile LAS unsigned*)(lds + LDS_TOTAL - 16);
    if (threadIdx.x == 0) { xbw[0] = 0u; xbw[1] = 0u; xbw[2] = 0u; xbw[3] = 0u; }
    __syncthreads();
    char* ws = P.ws; const int gid = blockIdx.x, gsz = gridDim.x;
    int* ctrl = (int*)(ws + OFF_CTRL); float* mod = (float*)(ws + OFF_MOD); float* rope = (float*)(ws + OFF_ROPE);
    XcdBarrier bar = xcd_barrier_post((unsigned*)ctrl, xbw);
    int* eidx = (int*)(ws + OFF_EIDX); float* gate = (float*)(ws + OFF_GATE); int* list = (int*)(ws + OFF_LIST); int* posin = (int*)(ws + OFF_POSIN);
    char* wmix = ws + OFF_WMIX; char* wexp = ws + OFF_WEXP;
    bf16_t* h = (bf16_t*)(ws + OFF_H); bf16_t* mixed = (bf16_t*)(ws + OFF_MIXED); bf16_t* u = (bf16_t*)(ws + OFF_U); bf16_t* q = (bf16_t*)(ws + OFF_Q); bf16_t* k = (bf16_t*)(ws + OFF_K);
    bf16_t* v = (bf16_t*)(ws + OFF_V); bf16_t* sgp = (bf16_t*)(ws + OFF_SGP); bf16_t* sga = (bf16_t*)(ws + OFF_SGA); bf16_t* poolo = (bf16_t*)(ws + OFF_POOLO);
    bf16_t* attno = (bf16_t*)(ws + OFF_ATTNO); bf16_t* vt = (bf16_t*)(ws + OFF_VT); bf16_t* ypool = (bf16_t*)(ws + OFF_YPOOL); bf16_t* merged = (bf16_t*)(ws + OFF_MERGED);
    bf16_t* x1b = (bf16_t*)(ws + OFF_X1B);
    unsigned char* h2 = (unsigned char*)(ws + OFF_H2); unsigned char* act = (unsigned char*)(ws + OFF_ACT); unsigned char* yslot = (unsigned char*)(ws + OFF_YSLOT);

    PHASE(0) {
        phase_ada_rope(lds, P.c, P.w_ada, P.b_ada, mod, rope, gid);
        unsigned* buf = (unsigned*)shm;
        if (gid >= 192) {
            cvt_w8(P.w_out, D, 0, 32, 16, D, (unsigned char*)(ws + OFF_W8O), gid - 192, 64, buf);
            cvt_w8(P.w_bp, D, 0, 32, 8, 1024, (unsigned char*)(ws + OFF_W8P), gid - 192, 64, buf);
            cvt_w8(P.w_ba, D, 0, 32, 16, D, (unsigned char*)(ws + OFF_W8A), gid - 192, 64, buf); }
        cvt_mix(P.w_in, P.pool_w, P.w_bp, P.w_ba, P.w_out, wmix, WM_IN, WM_POOL, WM_BP, WM_BA, WM_OUT, gid, gsz, buf);
        cvt_w8(P.w_in, INW, 0, 176, 16, D, (unsigned char*)(ws + OFF_W8G), gid, gsz, buf);
        { bf16_t* wrt = (bf16_t*)(ws + OFF_WRT);
          for (int i = gid * 512 + threadIdx.x; i < NE * D; i += gsz * 512) { const int e = i >> 11, d = i & (D - 1); const float w = P.w_router[d * NE + e];
              const unsigned hb = mg::cvt_pk_bf16(w, 0.f) & 0xffffu; const float hf = __uint_as_float(hb << 16); wrt[i] = (bf16_t)hb; wrt[NE * D + i] = (bf16_t)(mg::cvt_pk_bf16(w - hf, 0.f) & 0xffffu); } }
    }
    SEAM(0);
    PHASE(1) phase_norm_mod(P.x, P.norm1_w, mod, h, (unsigned char*)(ws + OFF_H8), gid, gsz);
    SEAM(1);
    PHASE(2) {
        if (gid < NGEMM) {
            if (threadIdx.x < 256) tbl[threadIdx.x] = (threadIdx.x == TB_TSTART + 65) ? 64 : 0;
            __syncthreads();
            mg::MoeSched<false, 44> S; S.G = NGEMM; S.c = gid; S.tb = tbl; S.list = list; S.W = (const char*)(ws + OFF_W8G) - (size_t)64 * 1024 * D;
            mg::gemm_phase<mg::EpiSigM, mg::MoeSched<false, 44>, true>(lds, (const char*)(ws + OFF_H8), D, S, mg::EpiSigM{u, q, k, v, sgp, sga, rope});
        } else cvt_experts8(P.wg, P.wu, P.wd, P.sg, P.su, P.sd, wexp, WE_GU, WE_D, gid - NGEMM, gsz - NGEMM, (unsigned*)shm); }
    SEAM(2);
    PHASE(4) {
        pool_pre_unit(u, mixed, gid >> 2, gid & 3);
        asm volatile("s_waitcnt vmcnt(0)" ::: "memory"); __syncthreads();
        if (threadIdx.x == 0) { __builtin_amdgcn_fence(__ATOMIC_ACQUIRE, "agent"); asm volatile("s_waitcnt vmcnt(0)" ::: "memory"); }
        __syncthreads();
        { mg::PoolSched S; S.G = gsz; S.c = gid; S.Bt = wmix + WM_POOL; mg::gemm_phase<mg::EpiPool, mg::PoolSched>(lds, (const char*)mixed, 256, S, mg::EpiPool{(unsigned char*)poolo, P.pool_scale}); }
        at::attn_phase(lds, q, k, v, attno, P.lq1, P.lk1, P.lq2, P.lk2, P.subln_w, gid, gsz); }
    SEAM(4);
    PHASE(5) {
        if (threadIdx.x < 256) tbl[threadIdx.x] = (threadIdx.x == TB_TSTART + 65) ? 64 : 0;
        __syncthreads();
        { mg::MoeSched<false, 8, 1024, 1024> S; S.G = gsz; S.c = gid; S.tb = tbl; S.list = list; S.W = (const char*)(ws + OFF_W8P) - (size_t)64 * 1024 * 1024;
          mg::gemm_phase<mg::EpiGateM<0>, mg::MoeSched<false, 8, 1024, 1024>, true>(lds, (const char*)poolo, 1024, S, mg::EpiGateM<0>{(void*)ypool, sgp, nullptr}); }
        { mg::MoeSched<false, 8> S; S.G = gsz; S.c = gid; S.tb = tbl; S.list = list; S.W = (const char*)(ws + OFF_W8A) - (size_t)64 * 1024 * D;
          mg::gemm_phase<mg::EpiGateM<1>, mg::MoeSched<false, 8>, true>(lds, (const char*)attno, D, S, mg::EpiGateM<1>{(void*)merged, sga, ypool}); } }
    SEAM(5);
    PHASE(6) {
        if (threadIdx.x < 256) tbl[threadIdx.x] = (threadIdx.x == TB_TSTART + 65) ? 64 : 0;
        __syncthreads();
        mg::MoeSched<false, 8> S; S.G = gsz; S.c = gid; S.tb = tbl; S.list = list; S.W = (const char*)(ws + OFF_W8O) - (size_t)64 * 1024 * D;
        mg::gemm_phase<mg::EpiOutM, mg::MoeSched<false, 8>, true>(lds, (const char*)merged, D, S, mg::EpiOutM{x1b, P.x, mod}); }
    SEAM(6);
    PHASE(7) phase_router(lds, tbl, x1b, P.norm2_w, mod, (const bf16_t*)(ws + OFF_WRT), P.router_bias, h2, eidx, gate, ctrl, list, posin, gid, gsz);
    SEAM(7);
    PHASE(8) { moe_tables(tbl, ctrl); mg::MoeSched<false> S; S.G = gsz; S.c = gid; S.tb = tbl; S.list = list; S.W = wexp + WE_GU;
        mg::gemm_phase<mg::EpiAct, mg::MoeSched<false>, true>(lds, (const char*)h2, D, S, mg::EpiAct{act}); }
    SEAM(8);
    PHASE(9) { moe_tables(tbl, ctrl); mg::MoeSched<true> S; S.G = gsz; S.c = gid; S.tb = tbl; S.list = list; S.W = wexp + WE_D;
        mg::gemm_phase<mg::EpiDown, mg::MoeSched<true>, true>(lds, (const char*)act, ED, S, mg::EpiDown{yslot}); }
    SEAM(9);
    PHASE(10) { moe_tables(tbl, ctrl); phase_final(P.out, x1b, yslot, eidx, posin, gate, tbl, mod, P.final_w, gid, gsz); }
}

#ifndef MK_SPLIT
#define MK_SPLIT 0
#endif
extern "C" void kernel_launch(void* const* d_in, const int* in_sizes, int n_in, void* d_out, int out_size, void* d_ws, size_t ws_size, hipStream_t stream) {
    if (ws_size < WS_NEED) return;
    static int ready = 0;
    if (!ready) {
        if (hipFuncSetAttribute((const void*)fwd, hipFuncAttributeMaxDynamicSharedMemorySize, LDS_TOTAL) != hipSuccess) return;
        int per_cu = 0; if (hipOccupancyMaxActiveBlocksPerMultiprocessor(&per_cu, (const void*)fwd, 512, LDS_TOTAL) != hipSuccess || per_cu < 1) return;
        ready = 1;
    }
    Params P{};
    const float** pp = (const float**)&P; for (int i = 0; i < 26; ++i) pp[i] = (const float*)d_in[i];
    P.out = (float*)d_out; P.ws = (char*)d_ws;
    (void)hipMemsetAsync(d_ws, 0, 64 * 1024, stream);
#if MK_SPLIT
    for (int ph = 0; ph < 11; ++ph) { P.p_lo = ph; P.p_hi = ph + 1; hipLaunchKernelGGL(fwd, dim3(256), dim3(512), LDS_TOTAL, stream, P); }
#elif defined(MK_PROBE)
    P.p_lo = 0; P.p_hi = MK_PROBE + 1; hipLaunchKernelGGL(fwd, dim3(256), dim3(512), LDS_TOTAL, stream, P);
    (void)hipMemsetAsync(d_ws, 0, 4096 * 4, stream);
    P.p_lo = MK_PROBE; P.p_hi = 11; hipLaunchKernelGGL(fwd, dim3(256), dim3(512), LDS_TOTAL, stream, P);
#else
    P.p_lo = 0; P.p_hi = 11; hipLaunchKernelGGL(fwd, dim3(256), dim3(512), LDS_TOTAL, stream, P);
#endif
}
```

```cpp
#include <hip/hip_runtime.h>
#include <stdint.h>

typedef unsigned short bf16_t;
#define DEV __device__ __forceinline__

constexpr int T = 16384, D = 2048, SEQ = 2048, NBATCH = 8, INW = 11264, NE = 64, ED = 512, TOPK = 8;
constexpr float NORM_EPS = 1e-6f, SUBLN_EPS = 1e-5f, LAMBDA_INIT = 0.2f;

DEV float bf2f(bf16_t v) { return __uint_as_float(((unsigned)v) << 16); }
DEV bf16_t f2bf(float f) { unsigned u = __float_as_uint(f); u += 0x7FFFu + ((u >> 16) & 1u); return (bf16_t)(u >> 16); }
DEV float sigm(float x) { return 1.0f / (1.0f + expf(-x)); }
DEV float wave_sum(float v) { for (int o = 32; o >= 1; o >>= 1) v += __shfl_xor(v, o); return v; }
DEV float wave_max(float v) { for (int o = 32; o >= 1; o >>= 1) v = fmaxf(v, __shfl_xor(v, o)); return v; }

constexpr size_t MiB = 1024 * 1024;
constexpr size_t OFF_CTRL = 0;
constexpr size_t OFF_MOD = 64 * 1024;
constexpr size_t OFF_ROPE = OFF_MOD + 8 * 12288 * 4;
constexpr size_t OFF_EIDX = 1 * MiB;
constexpr size_t OFF_GATE = OFF_EIDX + 512 * 1024;
constexpr size_t OFF_LIST = 2 * MiB;
constexpr size_t OFF_WRT = 6 * MiB;
constexpr size_t OFF_POSIN = OFF_WRT + 512 * 1024;
constexpr size_t OFF_WEXP = 8 * MiB;
constexpr size_t OFF_ACT0 = 398 * MiB;
constexpr size_t OFF_WMIX = OFF_ACT0;
constexpr size_t OFF_H = OFF_ACT0 + 65 * MiB;
constexpr size_t OFF_MIXED = OFF_H;
constexpr size_t OFF_U = OFF_H + 64 * MiB;
constexpr size_t OFF_Q = OFF_U + 32 * MiB;
constexpr size_t OFF_K = OFF_Q + 64 * MiB;
constexpr size_t OFF_V = OFF_K + 64 * MiB;
constexpr size_t OFF_SGP = OFF_V + 64 * MiB;
constexpr size_t OFF_SGA = OFF_SGP + 64 * MiB;
constexpr size_t OFF_POOLO = OFF_SGA + 64 * MiB;
constexpr size_t OFF_ATTNO = OFF_POOLO + 32 * MiB;
constexpr size_t OFF_VT = OFF_ATTNO + 64 * MiB;
constexpr size_t OFF_X1B = OFF_ATTNO;
constexpr size_t OFF_W8G = OFF_WMIX;
constexpr size_t OFF_H8 = OFF_VT + 8 * MiB;
constexpr size_t OFF_W8O = OFF_VT + 40 * MiB;
constexpr size_t OFF_W8P = OFF_VT + 44 * MiB;
constexpr size_t OFF_W8A = OFF_VT + 46 * MiB;
constexpr size_t OFF_YPOOL = OFF_Q;
constexpr size_t OFF_MERGED = OFF_K;
constexpr size_t OFF_H2 = OFF_ACT0;
constexpr size_t OFF_ACT = OFF_H2 + 64 * MiB;
constexpr size_t OFF_YSLOT = OFF_ACT + 145 * MiB;
constexpr size_t WS_NEED = OFF_VT + 64 * MiB;

constexpr int C_CNT = 4096;
constexpr int C_ROWBASE = 4352;
constexpr int C_TSTART = 4480;

constexpr int TB_CNT = 0, TB_ROWBASE = 64, TB_TSTART = 160;
#define LAS __attribute__((address_space(3)))
typedef short bf16x8 __attribute__((ext_vector_type(8)));
typedef float f32x4 __attribute__((ext_vector_type(4)));
typedef float f32x16 __attribute__((ext_vector_type(16)));
typedef unsigned u32x4 __attribute__((ext_vector_type(4)));
typedef unsigned u32x2 __attribute__((ext_vector_type(2)));
namespace mg {
constexpr int BM = 256, BK = 64, HALF = 128, HTB = HALF * BK * 2, STAGE_BYTES = 8 * HTB, NXCD = 8, WGM = 8;
__host__ __device__ __forceinline__ int lds_byte(int r, int c) { const int st = (r >> 4) * 2 + (c >> 5), rr = r & 15, cc = c & 31, ob = rr * 64 + cc * 2; return st * 1024 + (ob ^ (((ob >> 9) & 1) << 5)); }
__host__ __device__ __forceinline__ void stage_rc(int b, int& R, int& C) { const int st = b / 1024, sb = b % 1024, swz = sb ^ (((sb >> 9) & 1) << 5); R = (st >> 1) * 16 + swz / 64; C = (st & 1) * 32 + (swz % 64) / 2; }
__host__ __device__ __forceinline__ int perm32(int rho) { const int n = rho >> 4, i = rho & 15; return 8 * (i >> 2) + 4 * n + (i & 3); }
DEV unsigned cvt_pk_bf16(float lo, float hi) { unsigned r; asm volatile("v_cvt_pk_bf16_f32 %0, %1, %2" : "=v"(r) : "v"(lo), "v"(hi)); return r; }

struct Unit { int pm, pn, e, rows, base; };

typedef int v8i32 __attribute__((ext_vector_type(8)));
typedef int v4i32 __attribute__((ext_vector_type(4)));
DEV v8i32 cat8(const bf16x8 a, const bf16x8 b) { const v4i32 x = (v4i32)a, y = (v4i32)b; return __builtin_shufflevector(x, y, 0, 1, 2, 3, 4, 5, 6, 7); }
template <class Epi, class Sched, bool F8 = false>
__device__ __forceinline__ void gemm_phase(LAS unsigned char* lds, const char* Abase, const int K, const Sched& S, const Epi& E) {
    const int tid = threadIdx.x, wid = __builtin_amdgcn_readfirstlane(tid >> 6), lane = tid & 63, wr = wid >> 2, wc = wid & 3, fr = lane & 15, fq = lane >> 4;
    const int KBy = F8 ? K : 2 * K, nt = KBy / 128;
    int Rs[2], Cs[2]; unsigned voffB[2];
#pragma unroll
    for (int i = 0; i < 2; ++i) { stage_rc(tid * 16 + i * 8192, Rs[i], Cs[i]); Cs[i] *= 2; const int Rb = Epi::PERM ? ((Rs[i] & ~31) + perm32(Rs[i] & 31)) : Rs[i]; voffB[i] = Sched::BTILED ? (unsigned)(tid * 16 + i * 8192) : (unsigned)(Rb * KBy + Cs[i]); }
    const size_t kstep = (size_t)(BK * 2);
    const size_t kstepB = Sched::BTILED ? (size_t)HTB : kstep;
    const size_t hstepB = Sched::BTILED ? (size_t)nt * HTB : (size_t)HALF * KBy;
    const unsigned ldsw = (unsigned)wid * 1024u;
    const int aoff = lds_byte(wr * 64 + fr, fq * 8), boff = lds_byte(wc * 32 + fr, fq * 8);
#define MG_SA(b, h) (((b) * 2 + (h)) * HTB)
#define MG_SB(b, h) ((4 + (b) * 2 + (h)) * HTB)
#define MG_STAGEB(bufoff, gbase) do { _Pragma("unroll") for (int _i = 0; _i < 2; ++_i) \
        __builtin_amdgcn_global_load_lds((const unsigned*)((const char*)(gbase) + voffB[_i]), (LAS unsigned*)(lds + (bufoff) + ldsw + _i * 8192), 16, 0, 0); } while (0)
#define MG_STAGEA(bufoff, koff, o0, o1) do { \
        __builtin_amdgcn_global_load_lds((const unsigned*)(Abase + (koff) + (o0)), (LAS unsigned*)(lds + (bufoff) + ldsw), 16, 0, 0); \
        __builtin_amdgcn_global_load_lds((const unsigned*)(Abase + (koff) + (o1)), (LAS unsigned*)(lds + (bufoff) + ldsw + 8192), 16, 0, 0); } while (0)
#define MG_LDA(dst, b, h) do { _Pragma("unroll") for (int m = 0; m < 4; ++m) _Pragma("unroll") for (int k = 0; k < 2; ++k) dst[m][k] = *(const LAS bf16x8*)(lds + MG_SA(b, h) + aoff + m * 2048 + k * 1024); } while (0)
#define MG_LDB(dst, b, h) do { _Pragma("unroll") for (int n = 0; n < 2; ++n) _Pragma("unroll") for (int k = 0; k < 2; ++k) dst[n][k] = *(const LAS bf16x8*)(lds + MG_SB(b, h) + boff + n * 2048 + k * 1024); } while (0)
#define MG_MMA(ai, bj, At, Bt) do { __builtin_amdgcn_s_setprio(1); _Pragma("unroll") for (int m = 0; m < 4; ++m) _Pragma("unroll") for (int n = 0; n < 2; ++n) { \
        if constexpr (F8) { const v8i32 b8_ = cat8(Bt[n][0], Bt[n][1]), a8_ = cat8(At[m][0], At[m][1]); asm volatile("v_mfma_f32_16x16x128_f8f6f4 %0, %1, %2, %0" : "+v"(acc[ai][bj][m][n]) : "v"(b8_), "v"(a8_)); } \
        else { _Pragma("unroll") for (int k = 0; k < 2; ++k) acc[ai][bj][m][n] = __builtin_amdgcn_mfma_f32_16x16x32_bf16(Bt[n][k], At[m][k], acc[ai][bj][m][n], 0, 0, 0); } } __builtin_amdgcn_s_setprio(0); } while (0)
#define MG_WAIT_V(n) asm volatile("s_waitcnt vmcnt(" #n ")" ::: "memory")
#define MG_WAIT_L(n) asm volatile("s_waitcnt lgkmcnt(" #n ")" ::: "memory")
#define MG_BAR __builtin_amdgcn_s_barrier()
#define MG_SCHED __builtin_amdgcn_sched_barrier(0)
    Unit cur, nxt; int ui = 0;
    if (!S.next(0, cur)) return;
    f32x4 acc[2][2][4][2];
#pragma unroll
    for (int a = 0; a < 2; ++a)
#pragma unroll
        for (int b = 0; b < 2; ++b)
#pragma unroll
            for (int m = 0; m < 4; ++m)
#pragma unroll
                for (int n = 0; n < 2; ++n) acc[a][b][m][n] = (f32x4){0.f, 0.f, 0.f, 0.f};
    bf16x8 At[4][2], B0[2][2], B1[2][2];
    unsigned c00 = S.a_off(cur, 0, Rs[0], Cs[0]), c01 = S.a_off(cur, 0, Rs[1], Cs[1]), c10 = S.a_off(cur, 1, Rs[0], Cs[0]), c11 = S.a_off(cur, 1, Rs[1], Cs[1]);
    unsigned n00 = c00, n01 = c01, n10 = c10, n11 = c11;
    const char* cB = S.b_ptr(cur);
    MG_STAGEB(MG_SB(0, 0), cB); MG_STAGEA(MG_SA(0, 0), 0, c00, c01); MG_STAGEB(MG_SB(0, 1), cB + hstepB); MG_STAGEA(MG_SA(0, 1), 0, c10, c11);
    if (wr == 1) MG_BAR;
    MG_WAIT_V(4); MG_BAR;
    MG_STAGEB(MG_SB(1, 0), cB + kstepB); MG_STAGEA(MG_SA(1, 0), kstep, c00, c01); MG_STAGEB(MG_SB(1, 1), cB + hstepB + kstepB);
    MG_WAIT_V(6); MG_BAR;
    for (;;) {
        const bool has_next = S.next(ui + 1, nxt);
        const char* nB = has_next ? S.b_ptr(nxt) : cB;
        if (has_next) { n00 = S.a_off(nxt, 0, Rs[0], Cs[0]); n01 = S.a_off(nxt, 0, Rs[1], Cs[1]); n10 = S.a_off(nxt, 1, Rs[0], Cs[0]); n11 = S.a_off(nxt, 1, Rs[1], Cs[1]); }
        else { n00 = c00; n01 = c01; n10 = c10; n11 = c11; }
#pragma unroll 1
        for (int t = 0; t < nt; t += 2) {
            const bool last = (t == nt - 2);
            const size_t k1 = (size_t)(t + 1) * kstep;
            const size_t k2 = last ? 0 : (size_t)(t + 2) * kstep, k3 = k2 + kstep;
            const unsigned x00 = last ? n00 : c00, x01 = last ? n01 : c01, x10 = last ? n10 : c10, x11 = last ? n11 : c11;
            const char* b2 = last ? nB : cB + (size_t)(t + 2) * kstepB; const char* b3 = b2 + kstepB;
            MG_LDB(B0, 0, 0); MG_SCHED; MG_LDA(At, 0, 0); MG_STAGEA(MG_SA(1, 1), k1, c10, c11);
            MG_WAIT_L(8); MG_BAR; MG_WAIT_L(0); MG_MMA(0, 0, At, B0); MG_BAR; MG_SCHED;
            MG_LDB(B1, 0, 1); MG_STAGEB(MG_SB(0, 0), b2);
            MG_BAR; MG_WAIT_L(0); MG_MMA(0, 1, At, B1); MG_BAR;
            MG_LDA(At, 0, 1); MG_STAGEA(MG_SA(0, 0), k2, x00, x01);
            MG_BAR; MG_WAIT_L(0); MG_MMA(1, 0, At, B0); MG_BAR; MG_SCHED;
            MG_STAGEB(MG_SB(0, 1), b2 + hstepB);
            MG_WAIT_V(6); MG_BAR; MG_MMA(1, 1, At, B1); MG_BAR;
            MG_LDB(B0, 1, 0); MG_SCHED; MG_LDA(At, 1, 0); MG_STAGEA(MG_SA(0, 1), k2, x10, x11);
            MG_WAIT_L(8); MG_BAR; MG_WAIT_L(0); MG_MMA(0, 0, At, B0); MG_BAR; MG_SCHED;
            MG_LDB(B1, 1, 1); MG_STAGEB(MG_SB(1, 0), b3);
            MG_BAR; MG_WAIT_L(0); MG_MMA(0, 1, At, B1); MG_BAR;
            MG_LDA(At, 1, 1); MG_STAGEA(MG_SA(1, 0), k3, x00, x01);
            MG_BAR; MG_WAIT_L(0); MG_MMA(1, 0, At, B0); MG_BAR; MG_SCHED;
            MG_STAGEB(MG_SB(1, 1), b3 + hstepB);
            MG_WAIT_V(6); MG_BAR; MG_MMA(1, 1, At, B1); MG_BAR;
        }
        if constexpr (F8) { asm volatile("s_nop 15\n\ts_nop 15" : "+v"(acc[0][0][0][0]), "+v"(acc[0][0][0][1]), "+v"(acc[0][0][1][0]), "+v"(acc[0][0][1][1]), "+v"(acc[0][0][2][0]), "+v"(acc[0][0][2][1]), "+v"(acc[0][0][3][0]), "+v"(acc[0][0][3][1]), "+v"(acc[0][1][0][0]), "+v"(acc[0][1][0][1]), "+v"(acc[0][1][1][0]), "+v"(acc[0][1][1][1]), "+v"(acc[0][1][2][0]), "+v"(acc[0][1][2][1]), "+v"(acc[0][1][3][0]), "+v"(acc[0][1][3][1]) :: "memory"); asm volatile("" : "+v"(acc[1][0][0][0]), "+v"(acc[1][0][0][1]), "+v"(acc[1][0][1][0]), "+v"(acc[1][0][1][1]), "+v"(acc[1][0][2][0]), "+v"(acc[1][0][2][1]), "+v"(acc[1][0][3][0]), "+v"(acc[1][0][3][1]), "+v"(acc[1][1][0][0]), "+v"(acc[1][1][0][1]), "+v"(acc[1][1][1][0]), "+v"(acc[1][1][1][1]), "+v"(acc[1][1][2][0]), "+v"(acc[1][1][2][1]), "+v"(acc[1][1][3][0]), "+v"(acc[1][1][3][1]) :: "memory"); }
        E(acc, cur, wr, wc, fr, fq);
        if (!has_next) break;
#pragma unroll
        for (int a = 0; a < 2; ++a)
#pragma unroll
            for (int b = 0; b < 2; ++b)
#pragma unroll
                for (int m = 0; m < 4; ++m)
#pragma unroll
                    for (int n = 0; n < 2; ++n) acc[a][b][m][n] = (f32x4){0.f, 0.f, 0.f, 0.f};
        cur = nxt; cB = nB; c00 = n00; c01 = n01; c10 = n10; c11 = n11; ++ui;
    }
    MG_WAIT_V(0);
    if (wr == 0) MG_BAR;
    MG_BAR;
#undef MG_SA
#undef MG_SB
#undef MG_STAGEA
#undef MG_STAGEB
#undef MG_LDA
#undef MG_LDB
#undef MG_MMA
#undef MG_WAIT_V
#undef MG_WAIT_L
#undef MG_BAR
#undef MG_SCHED
}

template <bool BT, int ELT = 2> struct DenseSchedT {
    static constexpr bool BTILED = BT;
    int nM, nN, nwg, G, c; int lda, acol; const char* Bt; int K;
    DEV void init(int M, int N, int G_, int c_, int lda_, int acol_, const void* Bt_, int K_) { nM = M / BM; nN = N / BM; nwg = nM * nN; G = G_; c = c_; lda = lda_; acol = acol_; Bt = (const char*)Bt_; K = K_; }
    DEV bool next(int i, Unit& u) const {
        const long L = (long)i * G + c; if (L >= nwg) return false;
        int wgid = (int)L; { const int q = nwg / NXCD, r = nwg % NXCD, xcd = wgid % NXCD, off = wgid / NXCD; wgid = (xcd < r ? xcd * (q + 1) : r * (q + 1) + (xcd - r) * q) + off; }
        const int nig = WGM * nN, gid = wgid / nig, fm = gid * WGM, gsz = (nM - fm) < WGM ? (nM - fm) : WGM;
        u.pm = fm + ((wgid % nig) % gsz); u.pn = (wgid % nig) / gsz; u.e = 0; u.rows = 256; u.base = 0; return true;
    }
    DEV unsigned a_off(const Unit& u, int h, int R, int Cb) const { return (unsigned)(((u.pm * BM + h * HALF + R) * lda + acol) * ELT + Cb); }
    DEV const char* b_ptr(const Unit& u) const { return Bt + (size_t)u.pn * BM * K * ELT; }
};
typedef DenseSchedT<false> DenseSched;
struct PoolSched {
    static constexpr bool BTILED = false;
    int G, c; const char* Bt;
    DEV bool next(int i, Unit& u) const { const int L = i * G + c; if (L >= 256) return false; u.pm = L >> 2; u.pn = 0; u.e = L & 3; u.rows = 256; u.base = 0; return true; }
    DEV unsigned a_off(const Unit& u, int h, int R, int Cb) const { return (unsigned)(((u.pm * BM + h * HALF + R) * 1024 + u.e * 256) * 2 + Cb); }
    DEV const char* b_ptr(const Unit& u) const { return Bt + (size_t)u.e * 256 * 256 * 2; }
};

DEV u32x4 pack8(const f32x4 a, const f32x4 b) { u32x4 w; w.x = cvt_pk_bf16(a[0], a[1]); w.y = cvt_pk_bf16(a[2], a[3]); w.z = cvt_pk_bf16(b[0], b[1]); w.w = cvt_pk_bf16(b[2], b[3]); return w; }
DEV void unpack8(const u32x4 w, f32x4& a, f32x4& b) { a[0] = __uint_as_float(w.x << 16); a[1] = __uint_as_float(w.x & 0xffff0000u); a[2] = __uint_as_float(w.y << 16); a[3] = __uint_as_float(w.y & 0xffff0000u);
    b[0] = __uint_as_float(w.z << 16); b[1] = __uint_as_float(w.z & 0xffff0000u); b[2] = __uint_as_float(w.w << 16); b[3] = __uint_as_float(w.w & 0xffff0000u); }
DEV float fsigm(float x) { return __builtin_amdgcn_rcpf(1.0f + __expf(-x)); }

DEV unsigned pk4_fp8(float a, float b, float c, float d) { int w = 0; w = __builtin_amdgcn_cvt_pk_fp8_f32(a, b, w, false); w = __builtin_amdgcn_cvt_pk_fp8_f32(c, d, w, true); return (unsigned)w; }
DEV unsigned pk4_u8(const f32x4 g) { const unsigned a = (unsigned)(g[0] * 255.0f + 0.5f), b = (unsigned)(g[1] * 255.0f + 0.5f), c = (unsigned)(g[2] * 255.0f + 0.5f), d = (unsigned)(g[3] * 255.0f + 0.5f); return a | (b << 8) | (c << 16) | (d << 24); }
DEV f32x4 un4_u8(unsigned w) { return (f32x4){(float)(w & 255u), (float)((w >> 8) & 255u), (float)((w >> 16) & 255u), (float)(w >> 24)} * (1.0f / 255.0f); }
struct EpiProj { static constexpr bool PERM = true; bf16_t *u, *q, *k, *v, *sgp, *sga; int pn0;
    DEV void operator()(const f32x4 (&acc)[2][2][4][2], const Unit& un, int wr, int wc, int fr, int fq) const {
        const int pn = un.pn + pn0; bf16_t* base; int ldc, ct; bool sg = false;
        if (pn < 4) { base = u; ldc = 1024; ct = pn; } else if (pn < 12) { base = q; ldc = D; ct = pn - 4; } else if (pn < 20) { base = k; ldc = D; ct = pn - 12; }
        else if (pn < 28) { base = v; ldc = D; ct = pn - 20; } else if (pn < 36) { base = sgp; ldc = D; ct = pn - 28; sg = true; } else { base = sga; ldc = D; ct = pn - 36; sg = true; }
        const int row0 = un.pm * BM + wr * 64 + fr, col0 = ct * BM + wc * 32 + 8 * fq;
#pragma unroll
        for (int ai = 0; ai < 2; ++ai)
#pragma unroll
            for (int m = 0; m < 4; ++m) { bf16_t* rowp = base + (size_t)(row0 + ai * HALF + m * 16) * ldc + col0;
#pragma unroll
                for (int bj = 0; bj < 2; ++bj) { f32x4 v0 = acc[ai][bj][m][0], v1 = acc[ai][bj][m][1];
                    if (sg) {
#pragma unroll
                        for (int j = 0; j < 4; ++j) { v0[j] = fsigm(v0[j]); v1[j] = fsigm(v1[j]); } }
                    *(u32x4*)(rowp + bj * HALF) = pack8(v0, v1); } }
    } };
struct EpiSig8 { static constexpr bool PERM = true; bf16_t *sgp, *sga;
    DEV void operator()(const f32x4 (&acc)[2][2][4][2], const Unit& un, int wr, int wc, int fr, int fq) const {
        bf16_t* base = un.pn < 8 ? sgp : sga; const int ct = un.pn & 7;
        const int row0 = un.pm * BM + wr * 64 + fr, col0 = ct * BM + wc * 32 + 8 * fq;
#pragma unroll
        for (int ai = 0; ai < 2; ++ai)
#pragma unroll
            for (int m = 0; m < 4; ++m) { bf16_t* rowp = base + (size_t)(row0 + ai * HALF + m * 16) * D + col0;
#pragma unroll
                for (int bj = 0; bj < 2; ++bj) { f32x4 v0 = acc[ai][bj][m][0] * (1.0f / 64.0f), v1 = acc[ai][bj][m][1] * (1.0f / 64.0f);
#pragma unroll
                    for (int j = 0; j < 4; ++j) { v0[j] = fsigm(v0[j]); v1[j] = fsigm(v1[j]); }
                    *(u32x4*)(rowp + bj * HALF) = pack8(v0, v1); } }
    } };
struct EpiSigM { static constexpr bool PERM = true; bf16_t *u, *q, *k, *v, *sgp, *sga; const float* rope;
    DEV void operator()(const f32x4 (&acc)[2][2][4][2], const Unit& un, int wr, int wc, int fr, int fq) const {
        const int pn = un.pn; bf16_t* base; int ldc, ct; bool sg = false;
        if (pn < 4) { base = u; ldc = 1024; ct = pn; } else if (pn < 12) { base = q; ldc = D; ct = pn - 4; } else if (pn < 20) { base = k; ldc = D; ct = pn - 12; }
        else if (pn < 28) { base = v; ldc = D; ct = pn - 20; } else if (pn < 36) { base = sgp; ldc = D; ct = pn - 28; sg = true; } else { base = sga; ldc = D; ct = pn - 36; sg = true; }
        const int col0 = ct * BM + wc * 32 + 8 * fq;
        const bool rot = (pn >= 4 && pn < 20) && wc == 0;
#pragma unroll
        for (int ai = 0; ai < 2; ++ai)
#pragma unroll
            for (int m = 0; m < 4; ++m) { const int rl = ai * HALF + wr * 64 + m * 16 + fr; const int row = un.base + rl; bf16_t* rowp = base + (size_t)row * ldc + col0;
                f32x4 cs0, cs1, sn0, sn1;
                if (rot) { const float* rp = rope + (row % SEQ) * 16 + 8 * (fq & 1); cs0 = *(const f32x4*)rp; cs1 = *(const f32x4*)(rp + 4); sn0 = *(const f32x4*)(rp + SEQ * 16); sn1 = *(const f32x4*)(rp + SEQ * 16 + 4);
                    if (fq < 2) { sn0 = -sn0; sn1 = -sn1; } }
#pragma unroll
                for (int bj = 0; bj < 2; ++bj) { f32x4 v0 = acc[ai][bj][m][0] * (1.0f / 64.0f), v1 = acc[ai][bj][m][1] * (1.0f / 64.0f);
                    if (sg) {
#pragma unroll
                        for (int j = 0; j < 4; ++j) { v0[j] = fsigm(v0[j]); v1[j] = fsigm(v1[j]); } }
                    if (rot) { f32x4 p0, p1;
#pragma unroll
                        for (int j = 0; j < 4; ++j) { const unsigned a0 = __float_as_uint(v0[j]), a1 = __float_as_uint(v1[j]);
                            const auto r0 = __builtin_amdgcn_permlane32_swap(a0, a0, false, false); const auto r1 = __builtin_amdgcn_permlane32_swap(a1, a1, false, false);
                            p0[j] = __uint_as_float(fq < 2 ? r0[1] : r0[0]); p1[j] = __uint_as_float(fq < 2 ? r1[1] : r1[0]); }
                        v0 = v0 * cs0 + p0 * sn0; v1 = v1 * cs1 + p1 * sn1; }
                    if (rl < un.rows) { if (sg) { u32x2 w; w.x = pk4_u8(v0); w.y = pk4_u8(v1); *(u32x2*)((unsigned char*)base + (size_t)row * D + col0 + bj * HALF) = w; }
                        else *(u32x4*)(rowp + bj * HALF) = pack8(v0, v1); } } }
    } };
struct EpiPool { static constexpr bool PERM = true; unsigned char* out; const float* scale;
    DEV void operator()(const f32x4 (&acc)[2][2][4][2], const Unit& un, int wr, int wc, int fr, int fq) const {
        const int row0 = un.pm * BM + wr * 64 + fr, col0 = un.e * 256 + wc * 32 + 8 * fq;
#pragma unroll
        for (int bj = 0; bj < 2; ++bj) { const f32x4 s0 = *(const f32x4*)(scale + col0 + bj * HALF), s1 = *(const f32x4*)(scale + col0 + bj * HALF + 4);
#pragma unroll
            for (int ai = 0; ai < 2; ++ai)
#pragma unroll
                for (int m = 0; m < 4; ++m) { const f32x4 v0 = acc[ai][bj][m][0] * s0, v1 = acc[ai][bj][m][1] * s1; u32x2 w; w.x = pk4_fp8(v0[0], v0[1], v0[2], v0[3]); w.y = pk4_fp8(v1[0], v1[1], v1[2], v1[3]);
                    *(u32x2*)(out + (size_t)(row0 + ai * HALF + m * 16) * 1024 + col0 + bj * HALF) = w; } }
    } };
template <int MODE> struct EpiGate { static constexpr bool PERM = true; bf16_t* out; const bf16_t* sg; const bf16_t* yp;
    DEV void operator()(const f32x4 (&acc)[2][2][4][2], const Unit& un, int wr, int wc, int fr, int fq) const {
        const int row0 = un.pm * BM + wr * 64 + fr, col0 = un.pn * BM + wc * 32 + 8 * fq;
#pragma unroll
        for (int ai = 0; ai < 2; ++ai)
#pragma unroll
            for (int m = 0; m < 4; ++m) { const size_t ro = (size_t)(row0 + ai * HALF + m * 16) * D + col0;
#pragma unroll
                for (int bj = 0; bj < 2; ++bj) { f32x4 g0, g1; unpack8(*(const u32x4*)(sg + ro + bj * HALF), g0, g1);
                    f32x4 v0 = g0 * acc[ai][bj][m][0], v1 = g1 * acc[ai][bj][m][1];
                    if (MODE == 1) { f32x4 y0, y1; unpack8(*(const u32x4*)(yp + ro + bj * HALF), y0, y1); v0 += y0; v1 += y1; }
                    *(u32x4*)(out + ro + bj * HALF) = pack8(v0, v1); } }
    } };
struct EpiGate8 { static constexpr bool PERM = true; unsigned char* out; const bf16_t* sg; const bf16_t* yp;
    DEV void operator()(const f32x4 (&acc)[2][2][4][2], const Unit& un, int wr, int wc, int fr, int fq) const {
        const int row0 = un.pm * BM + wr * 64 + fr, col0 = un.pn * BM + wc * 32 + 8 * fq;
#pragma unroll
        for (int ai = 0; ai < 2; ++ai)
#pragma unroll
            for (int m = 0; m < 4; ++m) { const size_t ro = (size_t)(row0 + ai * HALF + m * 16) * D + col0;
#pragma unroll
                for (int bj = 0; bj < 2; ++bj) { f32x4 g0, g1, y0, y1; unpack8(*(const u32x4*)(sg + ro + bj * HALF), g0, g1); unpack8(*(const u32x4*)(yp + ro + bj * HALF), y0, y1);
                    const f32x4 v0 = g0 * acc[ai][bj][m][0] + y0, v1 = g1 * acc[ai][bj][m][1] + y1;
                    u32x2 w; w.x = pk4_fp8(v0[0], v0[1], v0[2], v0[3]); w.y = pk4_fp8(v1[0], v1[1], v1[2], v1[3]); *(u32x2*)(out + ro + bj * HALF) = w; } }
    } };
template <int MODE> struct EpiGateM { static constexpr bool PERM = true; void* out; const bf16_t* sg; const bf16_t* yp;
    DEV void operator()(const f32x4 (&acc)[2][2][4][2], const Unit& un, int wr, int wc, int fr, int fq) const {
        const int col0 = un.pn * BM + wc * 32 + 8 * fq;
#pragma unroll
        for (int ai = 0; ai < 2; ++ai)
#pragma unroll
            for (int m = 0; m < 4; ++m) { const int rl = ai * HALF + wr * 64 + m * 16 + fr; const size_t ro = (size_t)(un.base + rl) * D + col0;
#pragma unroll
                for (int bj = 0; bj < 2; ++bj) { if (rl < un.rows) { const u32x2 gw = *(const u32x2*)((const unsigned char*)sg + ro + bj * HALF); const f32x4 g0 = un4_u8(gw.x), g1 = un4_u8(gw.y);
                    f32x4 v0 = g0 * acc[ai][bj][m][0] * (1.0f / 64.0f), v1 = g1 * acc[ai][bj][m][1] * (1.0f / 64.0f);
                    if (MODE == 1) { f32x4 y0, y1; unpack8(*(const u32x4*)(yp + ro + bj * HALF), y0, y1); v0 += y0; v1 += y1;
                        u32x2 w; w.x = pk4_fp8(v0[0], v0[1], v0[2], v0[3]); w.y = pk4_fp8(v1[0], v1[1], v1[2], v1[3]); *(u32x2*)((unsigned char*)out + ro + bj * HALF) = w; }
                    else *(u32x4*)((bf16_t*)out + ro + bj * HALF) = pack8(v0, v1); } } }
    } };
struct EpiOutM { static constexpr bool PERM = true; bf16_t* x1; const float* x; const float* mod;
    DEV void operator()(const f32x4 (&acc)[2][2][4][2], const Unit& un, int wr, int wc, int fr, int fq) const {
        const int col0 = un.pn * BM + wc * 32 + 8 * fq;
        const float* g1 = mod + (un.base / SEQ) * 12288 + 2 * D;
#pragma unroll
        for (int bj = 0; bj < 2; ++bj) { const f32x4 g0 = *(const f32x4*)(g1 + col0 + bj * HALF) * (1.0f / 64.0f), g4 = *(const f32x4*)(g1 + col0 + bj * HALF + 4) * (1.0f / 64.0f);
#pragma unroll
            for (int ai = 0; ai < 2; ++ai)
#pragma unroll
                for (int m = 0; m < 4; ++m) { const int rl = ai * HALF + wr * 64 + m * 16 + fr; const size_t ro = (size_t)(un.base + rl) * D + col0 + bj * HALF;
                    if (rl < un.rows) *(u32x4*)(x1 + ro) = pack8(*(const f32x4*)(x + ro) + g0 * acc[ai][bj][m][0], *(const f32x4*)(x + ro + 4) + g4 * acc[ai][bj][m][1]); } }
    } };
struct EpiOut { static constexpr bool PERM = true; bf16_t* x1; const float* x; const float* mod;
    DEV void operator()(const f32x4 (&acc)[2][2][4][2], const Unit& un, int wr, int wc, int fr, int fq) const {
        const int row0 = un.pm * BM + wr * 64 + fr, col0 = un.pn * BM + wc * 32 + 8 * fq;
        const float* g1 = mod + ((un.pm * BM) / SEQ) * 12288 + 2 * D;
#pragma unroll
        for (int bj = 0; bj < 2; ++bj) { const f32x4 g0 = *(const f32x4*)(g1 + col0 + bj * HALF), g4 = *(const f32x4*)(g1 + col0 + bj * HALF + 4);
#pragma unroll
            for (int ai = 0; ai < 2; ++ai)
#pragma unroll
                for (int m = 0; m < 4; ++m) { const size_t ro = (size_t)(row0 + ai * HALF + m * 16) * D + col0 + bj * HALF;
                    *(u32x4*)(x1 + ro) = pack8(*(const f32x4*)(x + ro) + g0 * acc[ai][bj][m][0], *(const f32x4*)(x + ro + 4) + g4 * acc[ai][bj][m][1]); } }
    } };

template <bool DOWN, int NN = (DOWN ? 8 : 4), int AP = D, int BP = D> struct MoeSched {
    static constexpr bool BTILED = false;
    int G, c; const LAS int* tb; const int* list; const char* W;
    static constexpr int nN = NN;
    DEV bool next(int i, Unit& u) const {
        const int L = i * G + c; const int total = tb[TB_TSTART + 65] * nN; if (L >= total) return false;
        const int mtg = L / nN; u.pn = L % nN;
        const int lane = threadIdx.x & 63; const int ts = tb[TB_TSTART + lane], te = tb[TB_TSTART + lane + 1];
        const unsigned long long bal = __ballot(mtg >= ts && mtg < te);
        const int e = bal ? (int)__builtin_ctzll(bal) : NE;
        const int t0 = __builtin_amdgcn_readfirstlane(tb[TB_TSTART + e]); const int cnt = e < NE ? __builtin_amdgcn_readfirstlane(tb[TB_CNT + e]) : T;
        u.e = e; u.pm = mtg - t0; const int rem = cnt - u.pm * BM; u.rows = rem < BM ? rem : BM; u.base = __builtin_amdgcn_readfirstlane(tb[TB_ROWBASE + e]) + u.pm * BM; return true;
    }
    DEV unsigned a_off(const Unit& u, int h, int R, int Cb) const {
        const int rl = h * HALF + R;
        if (DOWN) return (unsigned)((u.base + rl) * ED + Cb);
        int tok;
        if (u.e < NE) tok = (rl < u.rows) ? (list[u.e * T + u.pm * BM + rl] >> 3) : 0; else tok = u.pm * BM + rl;
        return (unsigned)(tok * AP + Cb);
    }
    DEV const char* b_ptr(const Unit& u) const { return DOWN ? W + ((size_t)u.e * D + (size_t)u.pn * BM) * ED : W + ((size_t)u.e * 1024 + (size_t)u.pn * BM) * BP; }
};
constexpr float WSCALE = 64.0f, WINV = 1.0f / 64.0f;
struct EpiAct { static constexpr bool PERM = true; unsigned char* act;
    DEV void operator()(const f32x4 (&acc)[2][2][4][2], const Unit& un, int wr, int wc, int fr, int fq) const {
        const int col0 = un.pn * HALF + wc * 32 + 8 * fq;
#pragma unroll
        for (int ai = 0; ai < 2; ++ai)
#pragma unroll
            for (int m = 0; m < 4; ++m) { const int rl = ai * HALF + wr * 64 + m * 16 + fr;
                f32x4 v0, v1;
#pragma unroll
                for (int j = 0; j < 4; ++j) { const float g0 = acc[ai][0][m][0][j] * WINV, g1 = acc[ai][0][m][1][j] * WINV;
                    v0[j] = g0 * (acc[ai][1][m][0][j] * WINV) * __builtin_amdgcn_rcpf(1.0f + __expf(-g0)); v1[j] = g1 * (acc[ai][1][m][1][j] * WINV) * __builtin_amdgcn_rcpf(1.0f + __expf(-g1)); }
                if (rl < un.rows) { u32x2 w; w.x = pk4_fp8(v0[0], v0[1], v0[2], v0[3]); w.y = pk4_fp8(v1[0], v1[1], v1[2], v1[3]); *(u32x2*)(act + (size_t)(un.base + rl) * ED + col0) = w; } }
    } };
constexpr float YSCALE = 16.0f, YINV = 1.0f / 16.0f;
struct EpiDown { static constexpr bool PERM = true; unsigned char* yact;
    DEV void operator()(const f32x4 (&acc)[2][2][4][2], const Unit& un, int wr, int wc, int fr, int fq) const {
        const int col0 = un.pn * BM + wc * 64 + 16 * fq; constexpr float sc = WINV * YSCALE;
#pragma unroll
        for (int ai = 0; ai < 2; ++ai)
#pragma unroll
            for (int m = 0; m < 4; ++m) { const int rl = ai * HALF + wr * 64 + m * 16 + fr;
                if (rl < un.rows) { u32x4 w;
                    { const f32x4 v = acc[ai][0][m][0] * sc; w.x = pk4_fp8(v[0], v[1], v[2], v[3]); } { const f32x4 v = acc[ai][0][m][1] * sc; w.y = pk4_fp8(v[0], v[1], v[2], v[3]); }
                    { const f32x4 v = acc[ai][1][m][0] * sc; w.z = pk4_fp8(v[0], v[1], v[2], v[3]); } { const f32x4 v = acc[ai][1][m][1] * sc; w.w = pk4_fp8(v[0], v[1], v[2], v[3]); }
                    *(u32x4*)(yact + (size_t)(un.base + rl) * D + col0) = w; } }
    } };
}

DEV int perm32_inv(int c) { return ((c >> 2) & 1) * 16 + (((c >> 3) << 2) | (c & 3)); }
DEV void cvt_tile(const float* src, size_t ldS, bf16_t* dst, size_t ldD, int k0, int n0, int drow0, unsigned* buf  , int tiled = 0) {
    const int tid = threadIdx.x, n4 = tid & 15, kp = tid >> 4;
#pragma unroll
    for (int i = 0; i < 2; ++i) {
        const float* p = src + (size_t)(k0 + 2 * kp + 64 * i) * ldS + n0 + 4 * n4;
        const f32x4 a = *(const f32x4*)p, b = *(const f32x4*)(p + ldS);
#pragma unroll
        for (int j = 0; j < 4; ++j) buf[(4 * n4 + j) * 65 + kp + 32 * i] = mg::cvt_pk_bf16(a[j], b[j]);
    }
    __syncthreads();
    const int ch = tid & 15, nn = tid >> 4;
#pragma unroll
    for (int i = 0; i < 2; ++i) { const int n = nn + 32 * i; u32x4 w; w.x = buf[n * 65 + 4 * ch]; w.y = buf[n * 65 + 4 * ch + 1]; w.z = buf[n * 65 + 4 * ch + 2]; w.w = buf[n * 65 + 4 * ch + 3];
        if (tiled) { const int ng = drow0 + n, kg = k0 + 8 * ch, rb = ng & 127, R = tiled == 2 ? ((rb & ~31) + perm32_inv(rb & 31)) : rb;
            *(u32x4*)((char*)dst + ((size_t)((ng >> 8) * 2 + ((ng >> 7) & 1)) * (ldD >> 6) + (kg >> 6)) * mg::HTB + mg::lds_byte(R, kg & 63)) = w; }
        else *(u32x4*)(dst + (size_t)(drow0 + n) * ldD + k0 + 8 * ch) = w; }
    __syncthreads();
}
DEV void cvt_tile8(const float* src, size_t ldS, unsigned char* dst, size_t ldD, int k0, int n0, int drow0, unsigned* buf) {
    const int tid = threadIdx.x, n4 = tid & 15, kq = tid >> 4;
    const float* p = src + (size_t)(k0 + 4 * kq) * ldS + n0 + 4 * n4;
    const f32x4 a = *(const f32x4*)p * mg::WSCALE, b = *(const f32x4*)(p + ldS) * mg::WSCALE, c = *(const f32x4*)(p + 2 * ldS) * mg::WSCALE, d = *(const f32x4*)(p + 3 * ldS) * mg::WSCALE;
#pragma unroll
    for (int j = 0; j < 4; ++j) buf[(4 * n4 + j) * 33 + kq] = mg::pk4_fp8(a[j], b[j], c[j], d[j]);
    __syncthreads();
    const int ch = tid & 7, n = tid >> 3; u32x4 w; w.x = buf[n * 33 + 4 * ch]; w.y = buf[n * 33 + 4 * ch + 1]; w.z = buf[n * 33 + 4 * ch + 2]; w.w = buf[n * 33 + 4 * ch + 3];
    *(u32x4*)(dst + (size_t)(drow0 + n) * ldD + k0 + 16 * ch) = w;
    __syncthreads();
}
struct CvtTile { const float* src; unsigned char* dst; int ldS, ldD, perm; };
DEV CvtTile cvt_decode(int g, const float* wg, const float* wu, const float* wd, const float* sg, const float* su, const float* sd, char* wexp, size_t we_gu, size_t we_d) {
    const int e = g / 384, r = g % 384, mat = r >> 7, t = r & 127; CvtTile c;
    if (mat < 2) { const int kt = t >> 3, n0 = (t & 7) * 64; const float* base = mat == 0 ? (e < NE ? wg + (size_t)e * D * ED : sg) : (e < NE ? wu + (size_t)e * D * ED : su);
        c.src = base + (size_t)kt * 128 * ED + n0; c.ldS = ED; c.ldD = D; c.perm = 0;
        c.dst = (unsigned char*)(wexp + we_gu) + ((size_t)e * 1024 + 256 * (n0 >> 7) + (n0 & 127) + (mat == 1 ? 128 : 0)) * D + kt * 128; }
    else { const int kt = t >> 5, n0 = (t & 31) * 64; const float* base = e < NE ? wd + (size_t)e * ED * D : sd;
        c.src = base + (size_t)kt * 128 * D + n0; c.ldS = D; c.ldD = ED; c.perm = 1;
        c.dst = (unsigned char*)(wexp + we_d) + ((size_t)e * D + (n0 & ~255) + 32 * ((n0 & 255) >> 6)) * ED + kt * 128; }
    return c;
}
DEV void cvt_w8(const float* src, int ldS, int c0, int nct, int nkb, int ldD, unsigned char* dst, int gid, int gsz, unsigned* buf) {
    const int tid = threadIdx.x, n4 = tid & 15, kq = tid >> 4, ch = tid & 7, n = tid >> 3; const int NG = nkb * nct;
    f32x4 a[4], b[4], c[4], d[4];
    int g0 = 4 * gid;
#define W8_LOAD(G) do { _Pragma("unroll") for (int q = 0; q < 4; ++q) { const int g = (G) + q, kt = g / nct, n0 = (g % nct) * 64; const float* p = src + (size_t)(kt * 128 + 4 * kq) * ldS + c0 + n0 + 4 * n4; \
            a[q] = *(const f32x4*)p; b[q] = *(const f32x4*)(p + ldS); c[q] = *(const f32x4*)(p + 2 * ldS); d[q] = *(const f32x4*)(p + 3 * ldS); } } while (0)
    if (g0 < NG) W8_LOAD(g0);
    for (; g0 < NG; g0 += 4 * gsz) {
#pragma unroll
        for (int q = 0; q < 4; ++q)
#pragma unroll
            for (int j = 0; j < 4; ++j) buf[q * 2112 + (4 * n4 + j) * 33 + kq] = mg::pk4_fp8(a[q][j] * 64.0f, b[q][j] * 64.0f, c[q][j] * 64.0f, d[q][j] * 64.0f);
        const int gc = g0;
        if (g0 + 4 * gsz < NG) W8_LOAD(g0 + 4 * gsz);
        asm volatile("s_waitcnt lgkmcnt(0)" ::: "memory"); __builtin_amdgcn_s_barrier(); asm volatile("" ::: "memory");
#pragma unroll
        for (int q = 0; q < 4; ++q) { const int g = gc + q, kt = g / nct, n0 = (g % nct) * 64; const unsigned* bq = buf + q * 2112 + n * 33 + 4 * ch; u32x4 w; w.x = bq[0]; w.y = bq[1]; w.z = bq[2]; w.w = bq[3];
            *(u32x4*)(dst + (size_t)(n0 + n) * ldD + kt * 128 + 16 * ch) = w; }
        asm volatile("s_waitcnt lgkmcnt(0)" ::: "memory"); __builtin_amdgcn_s_barrier(); asm volatile("" ::: "memory");
    }
#undef W8_LOAD
    __syncthreads();
}
DEV void cvt_experts8(const float* wg, const float* wu, const float* wd, const float* sg, const float* su, const float* sd, char* wexp, size_t we_gu, size_t we_d, int gid, int gsz, unsigned* buf) {
    const int tid = threadIdx.x, n4 = tid & 15, kq = tid >> 4, ch = tid & 7, n = tid >> 3; constexpr int NT = 65 * 384;
    f32x4 a[4], b[4], c[4], d[4]; CvtTile ct[4];
    int g0 = 4 * gid;
#define CVT_LOAD(G) do { _Pragma("unroll") for (int q = 0; q < 4; ++q) { ct[q] = cvt_decode((G) + q, wg, wu, wd, sg, su, sd, wexp, we_gu, we_d); \
            const float* p = ct[q].src + (size_t)(4 * kq) * ct[q].ldS + 4 * n4; \
            a[q] = *(const f32x4*)p; b[q] = *(const f32x4*)(p + ct[q].ldS); c[q] = *(const f32x4*)(p + 2 * ct[q].ldS); d[q] = *(const f32x4*)(p + 3 * ct[q].ldS); } } while (0)
    if (g0 < NT) CVT_LOAD(g0);
    for (; g0 < NT; g0 += 4 * gsz) {
        unsigned char* dstp[4]; int ldd[4], prm[4];
#pragma unroll
        for (int q = 0; q < 4; ++q) { dstp[q] = ct[q].dst; ldd[q] = ct[q].ldD; prm[q] = ct[q].perm; }
#pragma unroll
        for (int q = 0; q < 4; ++q)
#pragma unroll
            for (int j = 0; j < 4; ++j) buf[q * 2112 + (4 * n4 + j) * 33 + kq] = mg::pk4_fp8(a[q][j] * mg::WSCALE, b[q][j] * mg::WSCALE, c[q][j] * mg::WSCALE, d[q][j] * mg::WSCALE);
        if (g0 + 4 * gsz < NT) CVT_LOAD(g0 + 4 * gsz);
        asm volatile("s_waitcnt lgkmcnt(0)" ::: "memory"); __builtin_amdgcn_s_barrier(); asm volatile("" ::: "memory");
#pragma unroll
        for (int q = 0; q < 4; ++q) { const unsigned* bq = buf + q * 2112 + n * 33 + 4 * ch; u32x4 w; w.x = bq[0]; w.y = bq[1]; w.z = bq[2]; w.w = bq[3];
            const int rown = prm[q] ? (128 * ((n >> 3) & 1) + 8 * (n >> 4) + (n & 7)) : n;
            *(u32x4*)(dstp[q] + (size_t)rown * ldd[q] + 16 * ch) = w; }
        asm volatile("s_waitcnt lgkmcnt(0)" ::: "memory"); __builtin_amdgcn_s_barrier(); asm volatile("" ::: "memory");
    }
#undef CVT_LOAD
}
DEV void cvt_matrix(const float* src, int K, int N, bf16_t* dst, int& tbase, int first, int stride, unsigned* buf, int mode = 0, int tiled = 0) {
    const int nk = K / 128, nn = N / 64, ntile = nk * nn;
    int t = first - (tbase % stride); if (t < 0) t += stride;
    for (; t < ntile; t += stride) { const int kt = t / nn, ntl = t % nn, n0 = ntl * 64; const int dr = mode == 0 ? n0 : (256 * (n0 >> 7) + (n0 & 127) + (mode == 2 ? 128 : 0));
        cvt_tile(src, N, dst, K, kt * 128, n0, dr, buf, tiled); }
    tbase += ntile;
}

DEV void phase_rope(bf16_t* q, bf16_t* k, const float* rope, int gid, int gsz) {
    for (int it = gid * 512 + threadIdx.x; it < T * 32; it += gsz * 512) {
        const int ch = it & 15, which = (it >> 4) & 1, t = it >> 5, pos = t % SEQ;
        bf16_t* p = (which ? k : q) + (size_t)t * D + ch * 128;
        u32x4 a0 = *(const u32x4*)p, a1 = *(const u32x4*)(p + 8), b0 = *(const u32x4*)(p + 16), b1 = *(const u32x4*)(p + 24);
        f32x4 r1[4], r2[4]; mg::unpack8(a0, r1[0], r1[1]); mg::unpack8(a1, r1[2], r1[3]); mg::unpack8(b0, r2[0], r2[1]); mg::unpack8(b1, r2[2], r2[3]);
        const f32x4* cs = (const f32x4*)(rope + pos * 16); const f32x4* sn = (const f32x4*)(rope + SEQ * 16 + pos * 16);
        f32x4 o1[4], o2[4];
#pragma unroll
        for (int i = 0; i < 4; ++i) { const f32x4 c4 = cs[i], s4 = sn[i]; o1[i] = r1[i] * c4 - r2[i] * s4; o2[i] = r2[i] * c4 + r1[i] * s4; }
        *(u32x4*)p = mg::pack8(o1[0], o1[1]); *(u32x4*)(p + 8) = mg::pack8(o1[2], o1[3]); *(u32x4*)(p + 16) = mg::pack8(o2[0], o2[1]); *(u32x4*)(p + 24) = mg::pack8(o2[2], o2[3]);
    }
}
DEV void pool_pre_unit(const bf16_t* u, bf16_t* mixed, int pm, int e) {
    { const int it = (pm * 16 + ((int)threadIdx.x >> 5)) * 128 + 32 * e + ((int)threadIdx.x & 31);
        const int c8 = it & 127, t0 = (it >> 7) * 16, g = c8 >> 5, w = 2 << g, s0 = t0 % SEQ;
        const bf16_t* up = u + (size_t)t0 * 1024 + c8 * 8; bf16_t* mp = mixed + (size_t)t0 * 1024 + c8 * 8;
        f32x4 a0 = {0.f, 0.f, 0.f, 0.f}, a1 = a0, x0, x1;
#pragma unroll
        for (int j = 1; j < 16; ++j) { const bool ok = j < w && s0 - j >= 0; const float mk = ok ? 1.0f : 0.0f;
            mg::unpack8(*(const u32x4*)(up - (ptrdiff_t)(ok ? j : 0) * 1024), x0, x1); a0 += x0 * mk; a1 += x1 * mk; }
        u32x4 xr[16], yr[16];
#pragma unroll
        for (int i = 0; i < 16; ++i) { const bool ok = i >= 1 && s0 + i - w >= 0; xr[i] = *(const u32x4*)(up + (size_t)i * 1024); yr[i] = *(const u32x4*)(up + (ptrdiff_t)(ok ? i - w : i) * 1024); }
#pragma unroll
        for (int i = 0; i < 16; ++i) { const bool ok = i >= 1 && s0 + i - w >= 0; const float mk = ok ? 1.0f : 0.0f;
            mg::unpack8(xr[i], x0, x1); a0 += x0; a1 += x1;
            { f32x4 y0, y1; mg::unpack8(yr[i], y0, y1); a0 -= y0 * mk; a1 -= y1 * mk; }
            const int n = (s0 + i + 1) < w ? (s0 + i + 1) : w; const float inv = 1.0f / (float)n;
            *(u32x4*)(mp + (size_t)i * 1024) = mg::pack8(a0 * inv - x0, a1 * inv - x1);
        }
    }
}
DEV void phase_vt(const bf16_t* v, bf16_t* vt, unsigned* buf, int gid, int gsz) {
    const int tid = threadIdx.x;
    for (int tile = gid; tile < NBATCH * 8 * (SEQ / 64); tile += gsz) {
        const int kc = tile & 31, h = (tile >> 5) & 7, b = tile >> 8, k0 = kc * 64;
#pragma unroll
        for (int i = 0; i < 2; ++i) { const int cc = tid & 31, kp = (tid >> 5) + 16 * i;
            const bf16_t* p = v + (size_t)(b * SEQ + k0 + 2 * kp) * D + h * 256 + cc * 8;
            const u32x4 r0 = *(const u32x4*)p, r1 = *(const u32x4*)(p + D);
            const unsigned a[4] = {r0.x, r0.y, r0.z, r0.w}, c[4] = {r1.x, r1.y, r1.z, r1.w};
#pragma unroll
            for (int j = 0; j < 4; ++j) { buf[(8 * cc + 2 * j) * 33 + kp] = (a[j] & 0xffffu) | (c[j] << 16); buf[(8 * cc + 2 * j + 1) * 33 + kp] = (a[j] >> 16) | (c[j] & 0xffff0000u); }
        }
        __syncthreads();
#pragma unroll
        for (int i = 0; i < 4; ++i) { const int ch = tid & 7, c = (tid >> 3) + 64 * i; u32x4 w; w.x = buf[c * 33 + 4 * ch]; w.y = buf[c * 33 + 4 * ch + 1]; w.z = buf[c * 33 + 4 * ch + 2]; w.w = buf[c * 33 + 4 * ch + 3];
            *(u32x4*)(vt + ((size_t)(b * 8 + h) * 256 + c) * SEQ + k0 + 8 * ch) = w; }
        __syncthreads();
    }
}

namespace at {
constexpr int KB_ = 64 * 256, VB_ = 256 * 128, STG = 2 * KB_ + VB_;
struct TileOff { unsigned k0, k1, v0, v1; };
DEV TileOff tile_offsets(int wid, int lane) {
    TileOff t;
    { const int row = 8 * wid + (lane >> 4), ch = (lane & 15) ^ (row & 15); t.k0 = (unsigned)(row * D * 2 + ch * 16); }
    { const int row = 8 * wid + 4 + (lane >> 4), ch = (lane & 15) ^ (row & 15); t.k1 = (unsigned)(row * D * 2 + ch * 16); }
    { const int key = 8 * wid + (lane >> 5), c16 = (lane & 31) ^ ((key & 3) << 2); t.v0 = (unsigned)(key * D * 2 + c16 * 16); }
    { const int key = 8 * wid + 2 + (lane >> 5), c16 = (lane & 31) ^ ((key & 3) << 2); t.v1 = (unsigned)(key * D * 2 + c16 * 16); }
    return t;
}
DEV void issue_tile(LAS unsigned char* st, const char* kb, const char* vb, int key0, int wid, const TileOff& t) {
    const char* kt = kb + (size_t)key0 * D * 2; const char* vtp = vb + (size_t)key0 * D * 2;
    LAS unsigned char* kd = st + wid * 2048; LAS unsigned char* vd = st + 2 * KB_ + wid * 4096;
    __builtin_amdgcn_global_load_lds((const unsigned*)(kt + t.k0), (LAS unsigned*)(kd), 16, 0, 0);
    __builtin_amdgcn_global_load_lds((const unsigned*)(kt + t.k1), (LAS unsigned*)(kd + 1024), 16, 0, 0);
    __builtin_amdgcn_global_load_lds((const unsigned*)(kt + 256 + t.k0), (LAS unsigned*)(kd + KB_), 16, 0, 0);
    __builtin_amdgcn_global_load_lds((const unsigned*)(kt + 256 + t.k1), (LAS unsigned*)(kd + KB_ + 1024), 16, 0, 0);
    __builtin_amdgcn_global_load_lds((const unsigned*)(vtp + t.v0), (LAS unsigned*)(vd), 16, 0, 0);
    __builtin_amdgcn_global_load_lds((const unsigned*)(vtp + t.v1), (LAS unsigned*)(vd + 1024), 16, 0, 0);
    __builtin_amdgcn_global_load_lds((const unsigned*)(vtp + 4 * D * 2 + t.v0), (LAS unsigned*)(vd + 2048), 16, 0, 0);
    __builtin_amdgcn_global_load_lds((const unsigned*)(vtp + 4 * D * 2 + t.v1), (LAS unsigned*)(vd + 3072), 16, 0, 0);
}
struct SubBlk { int b, h, qblk; };
DEV int lane_id() { return (int)__builtin_amdgcn_mbcnt_hi(~0u, __builtin_amdgcn_mbcnt_lo(~0u, 0u)); }
DEV void load_q(bf16x8 (&qf)[8], const bf16_t* q, const SubBlk& sb, int wid) {
    int lane = lane_id(); asm volatile("" : "+v"(lane));
    const int c = wid >> 2, rg = wid & 3, l32 = lane & 31, hi = lane >> 5;
    const size_t tok = (size_t)sb.b * SEQ + sb.qblk * 128 + 32 * rg + l32;
#pragma unroll
    for (int d0 = 0; d0 < 8; ++d0) qf[d0] = *(const bf16x8*)(q + tok * D + sb.h * 256 + c * 128 + d0 * 16 + hi * 8);
}
DEV void attn_block(LAS unsigned char* lds, const bf16_t* q, const bf16_t* k, const bf16_t* vt, bf16_t* out, const SubBlk cur, const SubBlk nxt, const bool has_next, bf16x8 (&qf)[8], float lam, const float* subln_w, const int wid) {
    int lane = lane_id(); asm volatile("" : "+v"(lane));
    const int c = wid >> 2, rg = wid & 3, l32 = lane & 31, hi = lane >> 5;
    const int b = cur.b, h = cur.h, qblk = cur.qblk;
    const int q0w = qblk * 128 + 32 * rg, qpos = q0w + l32;
    f32x16 o[8]; float zero = 0.f; asm volatile("" : "+v"(zero));
#pragma unroll
    for (int cb = 0; cb < 8; ++cb)
#pragma unroll
        for (int r = 0; r < 16; ++r) o[cb][r] = zero;
    float m = -1e30f, lsum = 0.f;
    const int nt = 2 * qblk + 2;
    const char* kb = (const char*)(k + (size_t)b * SEQ * D + h * 256); const char* vb = (const char*)(vt + (size_t)b * SEQ * D + h * 256);
    const TileOff toff = tile_offsets(wid, lane);
    const int krow = ((l32 & ~0xC) | ((l32 & 4) << 1) | ((l32 & 8) >> 1)), kx = krow & 15;
    const unsigned kaddr = (unsigned)(c * KB_ + krow * 256 + (((hi ^ (kx & 1))) << 4) + ((kx >> 1) << 5));
    const int vq = (lane >> 2) & 3, vp = lane & 3;
    const unsigned vaddr = (unsigned)(2 * KB_ + hi * 4096 + vq * 512 + vq * 64 + ((lane >> 4) & 1) * 32 + (vp >> 1) * 16 + (vp & 1) * 8);
    constexpr float C2 = 0.08838834764831845f * 1.4426950408889634f;
    for (int j = 0; j < nt; ++j) {
        asm volatile("s_waitcnt vmcnt(0)" ::: "memory");
        __syncthreads();
        if (j + 1 < nt) issue_tile(lds + ((j + 1) & 1) * STG, kb, vb, (j + 1) * 64, wid, toff);
        else if (has_next) issue_tile(lds, (const char*)(k + (size_t)nxt.b * SEQ * D + nxt.h * 256), (const char*)(vt + (size_t)nxt.b * SEQ * D + nxt.h * 256), 0, wid, toff);
        const int k0 = j * 64;
        if (k0 <= q0w + 31) {
            LAS unsigned char* st = lds + (j & 1) * STG;
            f32x16 s0, s1;
#pragma unroll
            for (int r = 0; r < 16; ++r) { s0[r] = 0.f; s1[r] = 0.f; }
#define AT_SB() __builtin_amdgcn_sched_barrier(0)
#define AT_LDK(dst, dp) do { dst[0] = *(const LAS bf16x8*)(st + (kaddr ^ (unsigned)((2 * (dp)) << 5))); dst[1] = *(const LAS bf16x8*)(st + (kaddr ^ (unsigned)((2 * (dp)) << 5)) + 8192); \
                             dst[2] = *(const LAS bf16x8*)(st + (kaddr ^ (unsigned)((2 * (dp) + 1) << 5))); dst[3] = *(const LAS bf16x8*)(st + (kaddr ^ (unsigned)((2 * (dp) + 1) << 5)) + 8192); } while (0)
#define AT_MMK(src, dp) do { s0 = __builtin_amdgcn_mfma_f32_32x32x16_bf16(src[0], qf[2 * (dp)], s0, 0, 0, 0); s1 = __builtin_amdgcn_mfma_f32_32x32x16_bf16(src[1], qf[2 * (dp)], s1, 0, 0, 0); \
                             s0 = __builtin_amdgcn_mfma_f32_32x32x16_bf16(src[2], qf[2 * (dp) + 1], s0, 0, 0, 0); s1 = __builtin_amdgcn_mfma_f32_32x32x16_bf16(src[3], qf[2 * (dp) + 1], s1, 0, 0, 0); } while (0)
#define AT_LDV(dst, cb) do { dst[0] = *(const LAS bf16x8*)(st + vaddr + (cb) * 4096); dst[1] = *(const LAS bf16x8*)(st + (vaddr ^ 32u) + (cb) * 4096); \
                             dst[2] = *(const LAS bf16x8*)(st + (vaddr ^ 64u) + (cb) * 4096); dst[3] = *(const LAS bf16x8*)(st + (vaddr ^ 96u) + (cb) * 4096); } while (0)
#define AT_MMV(src, cb) do { o[cb] = __builtin_amdgcn_mfma_f32_32x32x16_bf16(src[0], pk[0], o[cb], 0, 0, 0); o[cb] = __builtin_amdgcn_mfma_f32_32x32x16_bf16(src[1], pk[1], o[cb], 0, 0, 0); \
                             o[cb] = __builtin_amdgcn_mfma_f32_32x32x16_bf16(src[2], pk[2], o[cb], 0, 0, 0); o[cb] = __builtin_amdgcn_mfma_f32_32x32x16_bf16(src[3], pk[3], o[cb], 0, 0, 0); } while (0)
            bf16x8 fa[2];
#define AT_LDK2(dst, d0) do { dst[0] = *(const LAS bf16x8*)(st + (kaddr ^ (unsigned)((d0) << 5))); dst[1] = *(const LAS bf16x8*)(st + (kaddr ^ (unsigned)((d0) << 5)) + 8192); } while (0)
#define AT_MMK2(src, d0) do { s0 = __builtin_amdgcn_mfma_f32_32x32x16_bf16(src[0], qf[d0], s0, 0, 0, 0); s1 = __builtin_amdgcn_mfma_f32_32x32x16_bf16(src[1], qf[d0], s1, 0, 0, 0); } while (0)
#pragma unroll
            for (int d0 = 0; d0 < 8; ++d0) { AT_LDK2(fa, d0); AT_MMK2(fa, d0); }
            AT_SB();
            if (k0 + 63 > q0w) {
                const float NEG = -__builtin_inff(); const int tq = k0 + 8 * hi - qpos;
#pragma unroll
                for (int r = 0; r < 16; ++r) { if (tq + (16 * (r >> 3) + (r & 7)) > 0) s0[r] = NEG; if (tq + (32 + 16 * (r >> 3) + (r & 7)) > 0) s1[r] = NEG; }
            }
            float mx = s0[0];
#pragma unroll
            for (int r = 1; r < 16; ++r) mx = fmaxf(mx, s0[r]);
#pragma unroll
            for (int r = 0; r < 16; ++r) mx = fmaxf(mx, s1[r]);
            mx = fmaxf(mx, __shfl_xor(mx, 32));
            float mn = m, alpha = 1.0f;
            const bool resc = !__all((mx - m) * C2 <= 8.0f);
            if (resc) { mn = fmaxf(m, mx); alpha = __builtin_amdgcn_exp2f((m - mn) * C2); m = mn; }
            const float mnl = -mn * C2;
            float ls = 0.f;
#pragma unroll
            for (int r = 0; r < 16; ++r) { s0[r] = __builtin_amdgcn_exp2f(fmaf(s0[r], C2, mnl)); s1[r] = __builtin_amdgcn_exp2f(fmaf(s1[r], C2, mnl)); ls += s0[r] + s1[r]; }
            lsum = lsum * alpha + ls;
            if (resc) {
#pragma unroll
                for (int cb = 0; cb < 8; ++cb)
#pragma unroll
                    for (int r = 0; r < 16; ++r) o[cb][r] *= alpha;
            }
            bf16x8 pk[4];
            { u32x4 w;
              w.x = mg::cvt_pk_bf16(s0[0], s0[1]); w.y = mg::cvt_pk_bf16(s0[2], s0[3]); w.z = mg::cvt_pk_bf16(s0[4], s0[5]); w.w = mg::cvt_pk_bf16(s0[6], s0[7]); pk[0] = *(bf16x8*)&w;
              w.x = mg::cvt_pk_bf16(s0[8], s0[9]); w.y = mg::cvt_pk_bf16(s0[10], s0[11]); w.z = mg::cvt_pk_bf16(s0[12], s0[13]); w.w = mg::cvt_pk_bf16(s0[14], s0[15]); pk[1] = *(bf16x8*)&w;
              w.x = mg::cvt_pk_bf16(s1[0], s1[1]); w.y = mg::cvt_pk_bf16(s1[2], s1[3]); w.z = mg::cvt_pk_bf16(s1[4], s1[5]); w.w = mg::cvt_pk_bf16(s1[6], s1[7]); pk[2] = *(bf16x8*)&w;
              w.x = mg::cvt_pk_bf16(s1[8], s1[9]); w.y = mg::cvt_pk_bf16(s1[10], s1[11]); w.z = mg::cvt_pk_bf16(s1[12], s1[13]); w.w = mg::cvt_pk_bf16(s1[14], s1[15]); pk[3] = *(bf16x8*)&w; }
#define AT_TR(dst, addr, off) asm volatile("ds_read_b64_tr_b16 %0, %1 offset:%2" : "=v"(dst) : "v"(addr), "i"(off))
#define AT_LDV2(dst, cb, hf) do { const unsigned va_ = stv + (vaddr ^ (unsigned)((cb) << 6)); u32x2 t0_, t1_, t2_, t3_; \
        AT_TR(t0_, va_, (2 * (hf)) * 8192); AT_TR(t1_, va_, (2 * (hf)) * 8192 + 2048); AT_TR(t2_, va_, (2 * (hf) + 1) * 8192); AT_TR(t3_, va_, (2 * (hf) + 1) * 8192 + 2048); \
        asm volatile("s_waitcnt lgkmcnt(0)" : "+v"(t0_), "+v"(t1_), "+v"(t2_), "+v"(t3_) :: "memory"); \
        { u32x4 w_; w_.x = t0_.x; w_.y = t0_.y; w_.z = t1_.x; w_.w = t1_.y; dst[0] = *(bf16x8*)&w_; w_.x = t2_.x; w_.y = t2_.y; w_.z = t3_.x; w_.w = t3_.y; dst[1] = *(bf16x8*)&w_; } } while (0)
#define AT_MMV2(src, cb, hf) do { o[cb] = __builtin_amdgcn_mfma_f32_32x32x16_bf16(src[0], pk[2 * (hf)], o[cb], 0, 0, 0); o[cb] = __builtin_amdgcn_mfma_f32_32x32x16_bf16(src[1], pk[2 * (hf) + 1], o[cb], 0, 0, 0); } while (0)
            AT_SB(); const unsigned stv = (unsigned)(unsigned long)st;
#pragma unroll
            for (int cb = 0; cb < 8; ++cb) { AT_LDV2(fa, cb, 0); AT_SB(); AT_MMV2(fa, cb, 0); AT_SB(); AT_LDV2(fa, cb, 1); AT_SB(); AT_MMV2(fa, cb, 1); AT_SB(); }
            AT_SB();
        }
    }
    lsum += __shfl_xor(lsum, 32);
    const float inv = 1.0f / lsum;
    if (has_next) load_q(qf, q, nxt, wid);
    __syncthreads();
    int lane2 = lane_id(); asm volatile("" : "+v"(lane2));
    const int hi2 = lane2 >> 5; const size_t tok2 = (size_t)b * SEQ + qblk * 128 + 32 * rg + (lane2 & 31);
    LAS unsigned* X = (LAS unsigned*)(lds + STG) + rg * 4096 + lane2;
    if (c == 1) {
#pragma unroll
        for (int cb = 0; cb < 8; ++cb)
#pragma unroll
            for (int r2 = 0; r2 < 8; ++r2) X[(cb * 8 + r2) * 64] = mg::cvt_pk_bf16(o[cb][2 * r2] * inv, o[cb][2 * r2 + 1] * inv);
    }
    __syncthreads();
    if (c == 0) {
        float ss = 0.f; const float lamv = *(const LAS float*)(lds + mg::STAGE_BYTES + 4800);
#pragma unroll
        for (int cb = 0; cb < 8; ++cb)
#pragma unroll
            for (int r2 = 0; r2 < 8; ++r2) { const unsigned w = X[(cb * 8 + r2) * 64];
                const float v0 = o[cb][2 * r2] * inv - lamv * __uint_as_float(w << 16), v1 = o[cb][2 * r2 + 1] * inv - lamv * __uint_as_float(w & 0xffff0000u);
                o[cb][2 * r2] = v0; o[cb][2 * r2 + 1] = v1; ss += v0 * v0 + v1 * v1; }
        ss += __shfl_xor(ss, 32);
        const float rn = rsqrtf(ss * (1.0f / 256.0f) + SUBLN_EPS) * (1.0f - LAMBDA_INIT);
        unsigned char* orow = (unsigned char*)out + tok2 * D + h * 256 + 4 * hi2; const LAS float* sw = (const LAS float*)(lds + mg::STAGE_BYTES + 6400) + 4 * hi2;
#pragma unroll
        for (int cb = 0; cb < 8; ++cb)
#pragma unroll
            for (int g = 0; g < 4; ++g) { const int col = 32 * cb + 8 * g; const f32x4 w = *(const LAS f32x4*)(sw + col);
                *(unsigned*)(orow + col) = mg::pk4_fp8(o[cb][4 * g] * rn * w[0], o[cb][4 * g + 1] * rn * w[1], o[cb][4 * g + 2] * rn * w[2], o[cb][4 * g + 3] * rn * w[3]); }
    }
}
DEV SubBlk sub_block(int sbi, int gid, int gsz) {
    const int cidx = gid + (sbi >> 1) * gsz, x = cidx & 7, y = (cidx >> 3) & 31, rnd = cidx >> 8, bh = rnd * 32 + x * 4 + (y >> 3), p = y & 7;
    SubBlk s; s.b = bh >> 3; s.h = bh & 7; s.qblk = (sbi & 1) ? 15 - p : p; return s;
}
DEV void attn_phase(LAS unsigned char* lds, const bf16_t* q, const bf16_t* k, const bf16_t* vt, bf16_t* out, const float* lq1, const float* lk1, const float* lq2, const float* lk2, const float* subln_w, int gid, int gsz) {
    const int lane = threadIdx.x & 63;
    float s1 = lq1[lane] * lk1[lane] + lq1[lane + 64] * lk1[lane + 64], s2 = lq2[lane] * lk2[lane] + lq2[lane + 64] * lk2[lane + 64];
    s1 = wave_sum(s1); s2 = wave_sum(s2);
    const float lam = expf(s1) - expf(s2) + LAMBDA_INIT;
    if (threadIdx.x == 0) *(LAS float*)(lds + mg::STAGE_BYTES + 4800) = lam;
    if (threadIdx.x < 64) ((LAS f32x4*)(lds + mg::STAGE_BYTES + 6400))[threadIdx.x] = ((const f32x4*)subln_w)[threadIdx.x];
    const int wid = __builtin_amdgcn_readfirstlane(threadIdx.x >> 6);
    const int nitem = gid < 512 ? (512 - gid + gsz - 1) / gsz : 0, nsb = 2 * nitem;
    if (nsb == 0) return;
    bf16x8 qf[8];
    { const SubBlk s0 = sub_block(0, gid, gsz); const TileOff toff = tile_offsets(wid, lane_id());
      __syncthreads();
      issue_tile(lds, (const char*)(k + (size_t)s0.b * SEQ * D + s0.h * 256), (const char*)(vt + (size_t)s0.b * SEQ * D + s0.h * 256), 0, wid, toff);
      load_q(qf, q, s0, wid); }
    for (int sbi = 0; sbi < nsb; ++sbi) {
        const SubBlk cur = sub_block(sbi, gid, gsz); const bool has_next = sbi + 1 < nsb; const SubBlk nxt = sub_block(has_next ? sbi + 1 : sbi, gid, gsz);
        attn_block(lds, q, k, vt, out, cur, nxt, has_next, qf, lam, subln_w, wid);
    }
    __syncthreads();
}
}


struct CvtTileB { const float* src; bf16_t* dst; int ldS, ldD, n0, k0, tiled; };
DEV CvtTileB cvt_decode_mix(int g, const float* w_in, const float* pool_w, const float* w_bp, const float* w_ba, const float* w_out, char* wmix, size_t o_in, size_t o_pool, size_t o_bp, size_t o_ba, size_t o_out) {
    CvtTileB c; int t, nn;
    { const int gg = g, grp = gg >> 3; t = gg & 7; nn = 4; c.src = pool_w + grp * 65536; c.dst = (bf16_t*)(wmix + o_pool) + grp * 65536; c.ldS = 256; c.ldD = 256; c.tiled = 0; }
    c.k0 = (t / nn) * 128; c.n0 = (t % nn) * 64; return c;
}
DEV void cvt_mix(const float* w_in, const float* pool_w, const float* w_bp, const float* w_ba, const float* w_out, char* wmix, size_t o_in, size_t o_pool, size_t o_bp, size_t o_ba, size_t o_out, int gid, int gsz, unsigned* buf) {
    const int tid = threadIdx.x, n4 = tid & 15, kp = tid >> 4, ch = tid & 15, nn = tid >> 4; constexpr int NT = 32;
    for (int g0 = 4 * gid; g0 < NT; g0 += 4 * gsz) {
        f32x4 a[4][2], b[4][2]; CvtTileB ct[4];
#pragma unroll
        for (int q = 0; q < 4; ++q) { ct[q] = cvt_decode_mix(g0 + q, w_in, pool_w, w_bp, w_ba, w_out, wmix, o_in, o_pool, o_bp, o_ba, o_out);
#pragma unroll
            for (int i = 0; i < 2; ++i) { const float* p = ct[q].src + (size_t)(ct[q].k0 + 2 * kp + 64 * i) * ct[q].ldS + ct[q].n0 + 4 * n4; a[q][i] = *(const f32x4*)p; b[q][i] = *(const f32x4*)(p + ct[q].ldS); } }
#pragma unroll
        for (int q = 0; q < 4; ++q)
#pragma unroll
            for (int i = 0; i < 2; ++i)
#pragma unroll
                for (int j = 0; j < 4; ++j) buf[q * 4160 + (4 * n4 + j) * 65 + kp + 32 * i] = mg::cvt_pk_bf16(a[q][i][j], b[q][i][j]);
        __syncthreads();
#pragma unroll
        for (int q = 0; q < 4; ++q)
#pragma unroll
            for (int i = 0; i < 2; ++i) { const int n = nn + 32 * i; const unsigned* bq = buf + q * 4160 + n * 65 + 4 * ch; u32x4 w; w.x = bq[0]; w.y = bq[1]; w.z = bq[2]; w.w = bq[3];
                const int ng = ct[q].n0 + n, kg = ct[q].k0 + 8 * ch;
                if (ct[q].tiled) { const int rb = ng & 127, R = (rb & ~31) + perm32_inv(rb & 31);
                    *(u32x4*)((char*)ct[q].dst + ((size_t)((ng >> 8) * 2 + ((ng >> 7) & 1)) * (ct[q].ldD >> 6) + (kg >> 6)) * mg::HTB + mg::lds_byte(R, kg & 63)) = w; }
                else *(u32x4*)(ct[q].dst + (size_t)ng * ct[q].ldD + kg) = w; }
        __syncthreads();
    }
}
constexpr size_t WM_IN = 0, WM_POOL = (size_t)INW * D * 2, WM_BP = WM_POOL + 4 * 256 * 256 * 2, WM_BA = WM_BP + (size_t)D * 1024 * 2, WM_OUT = WM_BA + (size_t)D * D * 2;
constexpr size_t WE_GU = 0, WE_D = (size_t)65 * 1024 * D;
#define XB_TMO      128
#define XB_XCNT(j)  (256  + 64 * (j))
#define XB_XSUB(j)  (1280 + 64 * (j))
#define XB_XGEN(j)  (2304 + 64 * (j))
#define XB_TOP      3328
#define XB_TOPGEN   3392
#define XCD_BAR_WORDS 3456
#define XB_SPIN_CAP (1u << 18)

__device__ __forceinline__ unsigned xb_ld(unsigned* p)              { return __hip_atomic_load(p, __ATOMIC_RELAXED, __HIP_MEMORY_SCOPE_AGENT); }
__device__ __forceinline__ unsigned xb_add(unsigned* p, unsigned v) { return __hip_atomic_fetch_add(p, v, __ATOMIC_RELAXED, __HIP_MEMORY_SCOPE_AGENT); }
__device__ __forceinline__ unsigned xb_xcc_id() { return (unsigned)__builtin_amdgcn_s_getreg((3 << 11) | 20) & 0xFu; }
#define XB_SPIN(cond, bar) do { unsigned _sp = 0; while (cond) { __builtin_amdgcn_s_sleep(1); \
    if ((++_sp & 255u) == 0u) { if (xb_ld(&(bar)[XB_TMO])) break; if (_sp > XB_SPIN_CAP) { atomicAdd(&(bar)[XB_TMO], 1u); break; } } } } while (0)

struct XcdBarrier {
    unsigned* bar; unsigned x;
    volatile LAS unsigned* st;
};

__device__ __forceinline__ XcdBarrier xcd_barrier_post(unsigned* bar, volatile LAS unsigned* st) {
    XcdBarrier b; b.bar = bar; b.x = xb_xcc_id(); b.st = st;
    if (threadIdx.x == 0) (void)xb_add(&bar[XB_XCNT(b.x)], 1u);
    return b;
}
__device__ __forceinline__ void xcd_barrier_complete(unsigned* bar, unsigned x, unsigned& nloc, unsigned& nx) {
    const unsigned G = gridDim.x * gridDim.y * gridDim.z;
    unsigned sum, cnt, mine, sp = 0u;
    for (;;) {
        sum = 0u; cnt = 0u; mine = 0u;
#pragma unroll
        for (unsigned j = 0; j < 16; ++j) { const unsigned c = xb_ld(&bar[XB_XCNT(j)]); sum += c; cnt += (c > 0u) ? 1u : 0u; mine = (j == x) ? c : mine; }
        if (sum == G) break;
        __builtin_amdgcn_s_sleep(1);
        if ((++sp & 255u) == 0u) { if (xb_ld(&bar[XB_TMO])) break; if (sp > XB_SPIN_CAP) { atomicAdd(&bar[XB_TMO], 1u); break; } }
    }
    nloc = mine > 0u ? mine : 1u; nx = cnt > 0u ? cnt : 1u;
}

__device__ __forceinline__ void xcd_barrier(const XcdBarrier& b) {
    asm volatile("s_waitcnt vmcnt(0)" ::: "memory");
    __syncthreads();
    if (threadIdx.x == 0) {
        unsigned* bar = b.bar;
        __builtin_amdgcn_s_waitcnt(0);
        unsigned nloc = b.st[0], nx = b.st[1];
        if (nloc == 0u) { xcd_barrier_complete(bar, b.x, nloc, nx); b.st[0] = nloc; b.st[1] = nx; }
        const unsigned old = xb_add(&bar[XB_XSUB(b.x)], 1u);
        const unsigned gen = old / nloc;
        if (old + 1u == (gen + 1u) * nloc) {
            __builtin_amdgcn_fence(__ATOMIC_RELEASE, "agent");
            asm volatile("s_waitcnt vmcnt(0)" ::: "memory");
            const unsigned og = xb_add(&bar[XB_TOP], 1u);
            const unsigned tg = og / nx;
            if (og + 1u == (tg + 1u) * nx) xb_add(&bar[XB_TOPGEN], 1u);
            else XB_SPIN(xb_ld(&bar[XB_TOPGEN]) == tg, bar);
            __builtin_amdgcn_fence(__ATOMIC_ACQUIRE, "agent");
            xb_add(&bar[XB_XGEN(b.x)], 1u);
            asm volatile("s_waitcnt vmcnt(0)" ::: "memory");
        } else {
            XB_SPIN(xb_ld(&bar[XB_XGEN(b.x)]) == gen, bar);
            __builtin_amdgcn_fence(__ATOMIC_ACQUIRE, "agent");
            asm volatile("s_waitcnt vmcnt(0)" ::: "memory");
        }
    }
    __syncthreads();
}


DEV void phase_norm_mod(const float* x, const float* w, const float* mod, bf16_t* h, unsigned char* h8, int gid, int gsz) {
    const int wid = threadIdx.x >> 6, lane = threadIdx.x & 63;
    for (int r0 = (gid * 8 + wid) * 8; r0 < T; r0 += gsz * 64) {
        const int b = r0 / SEQ; const f32x4* wv = (const f32x4*)w; const f32x4* sh = (const f32x4*)(mod + b * 12288); const f32x4* sc = (const f32x4*)(mod + b * 12288 + D);
        f32x4 g[8], s4[8], v[8], vn[8];
#pragma unroll
        for (int i = 0; i < 8; ++i) { const int j = lane + 64 * i; g[i] = wv[j] * (sc[j] + 1.0f); s4[i] = sh[j]; v[i] = ((const f32x4*)(x + (size_t)r0 * D))[j]; }
#pragma unroll 1
        for (int k = 0; k < 8; ++k) { const int row = r0 + k; const f32x4* xn = (const f32x4*)(x + (size_t)(row + (k < 7 ? 1 : 0)) * D);
#pragma unroll
            for (int i = 0; i < 8; ++i) vn[i] = xn[lane + 64 * i];
            float ss = 0.f;
#pragma unroll
            for (int i = 0; i < 8; ++i) ss += v[i][0] * v[i][0] + v[i][1] * v[i][1] + v[i][2] * v[i][2] + v[i][3] * v[i][3];
            ss = wave_sum(ss); const float r = rsqrtf(ss * (1.0f / D) + NORM_EPS);
#pragma unroll
            for (int i = 0; i < 8; ++i) { const int j = lane + 64 * i; const f32x4 o = v[i] * r * g[i] + s4[i];
                *(unsigned*)(h8 + (size_t)row * D + 4 * j) = mg::pk4_fp8(o[0], o[1], o[2], o[3]); }
#pragma unroll
            for (int i = 0; i < 8; ++i) v[i] = vn[i]; }
    }
}
DEV void phase_ada_rope(LAS unsigned char* lds, const float* c, const float* w_ada, const float* b_ada, float* mod, float* rope, int gid) {
    const int tid = threadIdx.x;
    if (gid < 192) {
        LAS float* cs = (LAS float*)lds; LAS float* red = (LAS float*)(lds + 65536);
        for (int i = tid; i < NBATCH * D; i += 512) { const float cv = c[i]; cs[i] = cv / (1.0f + expf(-cv)); }
        __syncthreads();
        const int cg = tid & 15, kr = tid >> 4; f32x4 acc[8];
#pragma unroll
        for (int b = 0; b < 8; ++b) acc[b] = (f32x4){0.f, 0.f, 0.f, 0.f};
        const float* wp = w_ada + (size_t)kr * 12288 + gid * 64 + cg * 4;
#pragma unroll 1
        for (int i0 = 0; i0 < 64; i0 += 8) { f32x4 w4[8];
#pragma unroll
            for (int u = 0; u < 8; ++u) w4[u] = *(const f32x4*)(wp + (size_t)(i0 + u) * 32 * 12288);
#pragma unroll
            for (int u = 0; u < 8; ++u) { const int k = kr + 32 * (i0 + u);
#pragma unroll
                for (int b = 0; b < 8; ++b) acc[b] += w4[u] * cs[b * D + k]; } }
#pragma unroll
        for (int b = 0; b < 8; ++b) *(LAS f32x4*)(red + (kr * 8 + b) * 64 + cg * 4) = acc[b];
        __syncthreads();
        { const int b = tid >> 6, col = tid & 63; float sum = 0.f; for (int k2 = 0; k2 < 32; ++k2) sum += red[(k2 * 8 + b) * 64 + col];
          mod[b * 12288 + gid * 64 + col] = sum + b_ada[gid * 64 + col]; }
        __syncthreads();
    } else {
        const int i = (gid - 192) * 512 + tid; if (i < SEQ * 16) { const int pos = i >> 4, f = i & 15;
            const double inv = exp2(-(double)f * (18.931568569324174 / 16.0));
            const double ang = (double)pos * inv; const double n = rint(ang * 0.15915494309189535); const float r = (float)fma(-n, 6.283185307179586, ang);
            rope[i] = cosf(r); rope[SEQ * 16 + i] = sinf(r); }
    }
}
template <int CTRL> DEV float dppf(float v) { return __int_as_float(__builtin_amdgcn_update_dpp(0, __float_as_int(v), CTRL, 0xf, 0xf, false)); }
DEV float max8_dpp(float v) { v = fmaxf(v, dppf<0xB1>(v)); v = fmaxf(v, dppf<0x4E>(v)); return fmaxf(v, dppf<0x141>(v)); }
DEV float rdlane_f(float v, int l) { return __int_as_float(__builtin_amdgcn_readlane(__float_as_int(v), l)); }
DEV float max64_dpp(float v) { v = max8_dpp(v); v = fmaxf(v, dppf<0x140>(v));
    return fmaxf(fmaxf(rdlane_f(v, 0), rdlane_f(v, 16)), fmaxf(rdlane_f(v, 32), rdlane_f(v, 48))); }
DEV void phase_router(LAS unsigned char* lds, LAS int* tbl, const bf16_t* x1, const float* norm2_w, const float* mod, const bf16_t* wrt, const float* router_bias,
                      unsigned char* h2, int* eidx, float* gate, int* ctrl, int* list, int* posin, int gid, int gsz) {
    const int tid = threadIdx.x, wid = tid >> 6, lane = tid & 63;
    LAS int* hist = tbl + 512; LAS int* basev = tbl + 576; LAS int* lpos = tbl + 640;
    LAS float* rstd = (LAS float*)lds;
    LAS float* lg = (LAS float*)(lds + 1024);
    for (int grp = gid; grp < T / 64; grp += gsz) {
        const int t0 = grp * 64, b = t0 / SEQ;
        if (tid < 64) hist[tid] = 0;
        { LAS f32x4* gl = (LAS f32x4*)(lds + 49152); LAS f32x4* sl = (LAS f32x4*)(lds + 57344);
          const f32x4 g4 = ((const f32x4*)norm2_w)[tid] * (((const f32x4*)(mod + b * 12288 + 4 * D))[tid] + 1.0f); gl[tid] = g4; sl[tid] = ((const f32x4*)(mod + b * 12288 + 3 * D))[tid]; }
        for (int r = 0; r < 8; r += 2) { const int t = t0 + wid * 8 + r; const u32x4* xr = (const u32x4*)(x1 + (size_t)t * D); float ssa = 0.f, ssb = 0.f; u32x4 va[4], vb[4];
#pragma unroll
            for (int i = 0; i < 4; ++i) { va[i] = xr[lane + 64 * i]; vb[i] = xr[D / 8 + lane + 64 * i]; }
#pragma unroll
            for (int i = 0; i < 4; ++i) { f32x4 a0, a1, b0, b1; mg::unpack8(va[i], a0, a1); mg::unpack8(vb[i], b0, b1);
                ssa += a0[0] * a0[0] + a0[1] * a0[1] + a0[2] * a0[2] + a0[3] * a0[3] + a1[0] * a1[0] + a1[1] * a1[1] + a1[2] * a1[2] + a1[3] * a1[3];
                ssb += b0[0] * b0[0] + b0[1] * b0[1] + b0[2] * b0[2] + b0[3] * b0[3] + b1[0] * b1[0] + b1[1] * b1[1] + b1[2] * b1[2] + b1[3] * b1[3]; }
            ssa = wave_sum(ssa); ssb = wave_sum(ssb);
            if (lane == 0) { rstd[wid * 8 + r] = rsqrtf(ssa * (1.0f / D) + NORM_EPS); rstd[wid * 8 + r + 1] = rsqrtf(ssb * (1.0f / D) + NORM_EPS); } }
        __syncthreads();
        { const int mb = wid & 1, nb = (wid >> 1) & 1, kh = wid >> 2, l32 = lane & 31, kg = lane >> 5;
          const int t = t0 + 32 * mb + l32; const float rs = rstd[32 * mb + l32];
          const bf16_t* xr = x1 + (size_t)t * D + kh * 1024 + 16 * kg;
          const LAS float* gl = (const LAS float*)(lds + 49152) + kh * 1024 + 16 * kg; const LAS float* sl = (const LAS float*)(lds + 57344) + kh * 1024 + 16 * kg;
          const bf16_t* bh = wrt + (size_t)(32 * nb + l32) * D + kh * 1024 + 16 * kg; const bf16_t* bl = bh + NE * D;
          unsigned char* hrow = h2 + (size_t)t * D + kh * 1024 + 16 * kg;
          f32x16 acc;
#pragma unroll
          for (int r = 0; r < 16; ++r) acc[r] = 0.f;
#define RT_LOAD(X, B, kp_) do { const int ko_ = (kp_) * 32; mg::unpack8(*(const u32x4*)(xr + ko_), X[0], X[1]); mg::unpack8(*(const u32x4*)(xr + ko_ + 8), X[2], X[3]); \
              B[0] = *(const bf16x8*)(bh + ko_); B[1] = *(const bf16x8*)(bh + ko_ + 8); B[2] = *(const bf16x8*)(bl + ko_); B[3] = *(const bf16x8*)(bl + ko_ + 8); } while (0)
#define RT_STEP(X, B, kp_) do { const int ko_ = (kp_) * 32; f32x4 h[4]; \
              _Pragma("unroll") for (int q = 0; q < 4; ++q) h[q] = X[q] * rs * *(const LAS f32x4*)(gl + ko_ + 4 * q) + *(const LAS f32x4*)(sl + ko_ + 4 * q); \
              if (nb == 0) { u32x4 w16; w16.x = mg::pk4_fp8(h[0][0], h[0][1], h[0][2], h[0][3]); w16.y = mg::pk4_fp8(h[1][0], h[1][1], h[1][2], h[1][3]); \
                  w16.z = mg::pk4_fp8(h[2][0], h[2][1], h[2][2], h[2][3]); w16.w = mg::pk4_fp8(h[3][0], h[3][1], h[3][2], h[3][3]); *(u32x4*)(hrow + ko_) = w16; } \
              _Pragma("unroll") for (int hf = 0; hf < 2; ++hf) { u32x4 hi4 = mg::pack8(h[2 * hf], h[2 * hf + 1]); f32x4 e0, e1; mg::unpack8(hi4, e0, e1); \
                  const u32x4 lo4 = mg::pack8(h[2 * hf] - e0, h[2 * hf + 1] - e1); const bf16x8 ahi = *(const bf16x8*)&hi4, alo = *(const bf16x8*)&lo4; \
                  acc = __builtin_amdgcn_mfma_f32_32x32x16_bf16(ahi, B[hf], acc, 0, 0, 0); acc = __builtin_amdgcn_mfma_f32_32x32x16_bf16(alo, B[hf], acc, 0, 0, 0); \
                  acc = __builtin_amdgcn_mfma_f32_32x32x16_bf16(ahi, B[2 + hf], acc, 0, 0, 0); } } while (0)
          f32x4 xa[4], xb[4]; bf16x8 ba[4], bb[4];
          RT_LOAD(xa, ba, 0);
#pragma unroll 1
          for (int kp = 0; kp < 32; kp += 2) {
              RT_LOAD(xb, bb, kp + 1); __builtin_amdgcn_sched_barrier(0);
              RT_STEP(xa, ba, kp); __builtin_amdgcn_sched_barrier(0);
              RT_LOAD(xa, ba, (kp + 2 < 32 ? kp + 2 : kp)); __builtin_amdgcn_sched_barrier(0);
              RT_STEP(xb, bb, kp + 1); __builtin_amdgcn_sched_barrier(0);
          }
#undef RT_LOAD
#undef RT_STEP
#pragma unroll
          for (int r = 0; r < 16; ++r) lg[(kh * 64 + 32 * mb + (r & 3) + 8 * (r >> 2) + 4 * kg) * 64 + 32 * nb + l32] = acc[r];
        }
        __syncthreads();
        const float rbias = router_bias[lane];
        for (int r = 0; r < 8; ++r) {
            const int tl = wid * 8 + r, t = t0 + tl; const float logit = lg[tl * 64 + lane] + lg[(64 + tl) * 64 + lane];
            const float score = sigm(logit), biased = score + rbias; const int myg = lane >> 3;
            const float m1 = max8_dpp(biased);
            const unsigned long long b1 = __ballot(biased == m1); const int i1 = 8 * myg + (int)__builtin_ctz((unsigned)((b1 >> (8 * myg)) & 0xffull));
            const float m2 = max8_dpp(lane == i1 ? -INFINITY : biased);
            const float gs = m1 + m2;
            int grank = 0;
#pragma unroll
            for (int g = 0; g < 8; ++g) { const float og = rdlane_f(gs, 8 * g); grank += (og > gs || (og == gs && g < myg)) ? 1 : 0; }
            const bool gsel = grank < 4; float cur = gsel ? biased : -INFINITY; int rk = -1;
#pragma unroll
            for (int it = 0; it < TOPK; ++it) { const float mx = max64_dpp(cur); const unsigned long long bm = __ballot(cur == mx); const int sel = (int)__builtin_ctzll(bm);
                if (lane == sel) { rk = it; cur = -INFINITY; } }
            const bool chosen = rk >= 0; const float ssum = wave_sum(chosen ? score : 0.f);
            if (chosen) { eidx[t * 8 + rk] = lane; gate[t * 8 + rk] = score / ssum * 2.5f; lpos[tl * 8 + rk] = (lane << 16) | __hip_atomic_fetch_add(hist + lane, 1, __ATOMIC_RELAXED, __HIP_MEMORY_SCOPE_WORKGROUP); }
        }
        __syncthreads();
        if (tid < 64) basev[tid] = atomicAdd(&ctrl[C_CNT + tid], hist[tid]);
        __syncthreads();
        { const int v = lpos[tid], e = v >> 16, lp = v & 0xffff, slot = (t0 + (tid >> 3)) * 8 + (tid & 7); list[e * T + basev[e] + lp] = slot; posin[slot] = basev[e] + lp; }
        __syncthreads();
    }
}
DEV void moe_tables(LAS int* tbl, const int* ctrl) {
    __syncthreads();
    if (threadIdx.x < 64) tbl[TB_CNT + threadIdx.x] = ctrl[C_CNT + threadIdx.x];
    __syncthreads();
    if (threadIdx.x == 0) { int sr = 0, ts = 0; for (int e = 0; e < NE; ++e) { const int cn = tbl[TB_CNT + e]; tbl[TB_ROWBASE + e] = sr; tbl[TB_TSTART + e] = ts; sr += cn; ts += (cn + 255) >> 8; }
        tbl[TB_ROWBASE + NE] = sr; tbl[TB_TSTART + NE] = ts; tbl[TB_TSTART + NE + 1] = ts + T / 256; }
    __syncthreads();
}
DEV void phase_final(float* out, const bf16_t* x1, const unsigned char* yact, const int* eidx, const int* posin, const float* gate, LAS int* tbl, const float* mod, const float* fw, int gid, int gsz) {
    const int wid = threadIdx.x >> 6, lane = threadIdx.x & 63;
    const int r0w = (gid * 8 + wid) * 8; const float* g2 = mod + (r0w / SEQ) * 12288 + 5 * D;
    f32x4 g2r[2][4], fwr[2][4];
#pragma unroll
    for (int i = 0; i < 2; ++i)
#pragma unroll
        for (int q = 0; q < 4; ++q) { const int c0 = 16 * (lane + 64 * i) + 4 * q; g2r[i][q] = *(const f32x4*)(g2 + c0) * mg::YINV; fwr[i][q] = *(const f32x4*)(fw + c0); }
    int nrow_ = 0; float ng_ = 0.f;
    if (lane < 8) { const int sl = r0w * 8 + lane; nrow_ = tbl[TB_ROWBASE + eidx[sl]] + posin[sl]; ng_ = gate[sl]; }
    else if (lane == 8) { nrow_ = tbl[TB_ROWBASE + NE] + r0w; ng_ = 1.0f; }
#pragma unroll 1
    for (int row = r0w; row < r0w + 8; ++row) {
        float* xr = out + (size_t)row * D;
        const int myrow = nrow_; const float myg = ng_;
        { const int rn = row + 1 < r0w + 8 ? row + 1 : row;
          if (lane < 8) { const int sl = rn * 8 + lane; nrow_ = tbl[TB_ROWBASE + eidx[sl]] + posin[sl]; ng_ = gate[sl]; }
          else if (lane == 8) { nrow_ = tbl[TB_ROWBASE + NE] + rn; ng_ = 1.0f; } }
        f32x4 v[2][4]; float ss = 0.f;
#pragma unroll
        for (int i = 0; i < 2; ++i)
#pragma unroll
            for (int q = 0; q < 4; ++q) v[i][q] = (f32x4){0.f, 0.f, 0.f, 0.f};
#pragma unroll 1
        for (int kh = 0; kh < 3; ++kh) {
            u32x4 y[3][2]; float gk[3];
#pragma unroll
            for (int k = 0; k < 3; ++k) { const int rk = __shfl(myrow, kh * 3 + k); gk[k] = __shfl(myg, kh * 3 + k); const unsigned char* yb = yact + (size_t)rk * D + 16 * lane;
#pragma unroll
                for (int i = 0; i < 2; ++i) y[k][i] = *(const u32x4*)(yb + 1024 * i); }
#pragma unroll
            for (int k = 0; k < 3; ++k)
#pragma unroll
                for (int i = 0; i < 2; ++i) {
#pragma unroll
                    for (int q = 0; q < 4; ++q) { const int w = (int)y[k][i][q]; const auto lo = __builtin_amdgcn_cvt_pk_f32_fp8(w, false), hi = __builtin_amdgcn_cvt_pk_f32_fp8(w, true);
                        v[i][q][0] += gk[k] * lo[0]; v[i][q][1] += gk[k] * lo[1]; v[i][q][2] += gk[k] * hi[0]; v[i][q][3] += gk[k] * hi[1]; } }
        }
#pragma unroll
        for (int i = 0; i < 2; ++i)
#pragma unroll
            for (int q = 0; q < 4; ++q) { const int c0 = 16 * (lane + 64 * i) + 4 * q; const u32x2 xw = *(const u32x2*)(x1 + (size_t)row * D + c0);
                const f32x4 xv = {__uint_as_float(xw.x << 16), __uint_as_float(xw.x & 0xffff0000u), __uint_as_float(xw.y << 16), __uint_as_float(xw.y & 0xffff0000u)};
                v[i][q] = xv + g2r[i][q] * v[i][q];
                ss += v[i][q][0] * v[i][q][0] + v[i][q][1] * v[i][q][1] + v[i][q][2] * v[i][q][2] + v[i][q][3] * v[i][q][3]; }
        ss = wave_sum(ss); const float rn = rsqrtf(ss * (1.0f / D) + NORM_EPS);
#pragma unroll
        for (int i = 0; i < 2; ++i)
#pragma unroll
            for (int q = 0; q < 4; ++q) { const int c0 = 16 * (lane + 64 * i) + 4 * q; *(f32x4*)(xr + c0) = v[i][q] * rn * fwr[i][q]; }
    }
}

struct Params {
    const float *x, *c, *w_ada, *b_ada, *norm1_w, *w_in, *pool_w, *pool_scale, *w_bp, *lq1, *lk1, *lq2, *lk2, *subln_w, *w_ba, *w_out, *norm2_w, *w_router, *router_bias,
                *wg, *wu, *wd, *sg, *su, *sd, *final_w;
    float* out; char* ws; int p_lo, p_hi;
};
constexpr int LDS_TBL = mg::STAGE_BYTES, LDS_TOTAL = mg::STAGE_BYTES + 8192;
#define PHASE(i) if (P.p_lo <= (i) && (i) < P.p_hi)
#define SEAM(i) if (P.p_lo <= (i) && (i) + 1 < P.p_hi) xcd_barrier(bar)
constexpr int NGEMM = 188;
constexpr int INIT_ZERO_WORDS = 6144, INIT_FLAG_WORD = 8192; constexpr unsigned INIT_MAGIC = 0x600DF1A6u, INIT_DONE = 0x0D0E0D0Eu;
__global__ __launch_bounds__(512, 2) void fwd(const Params P) {
    extern __shared__ __attribute__((aligned(16))) unsigned char shm[];
    LAS unsigned char* lds = (LAS unsigned char*)shm; LAS int* tbl = (LAS int*)(lds + LDS_TBL);
    volatile LAS unsigned* xbw = (volatile LAS unsigned*)(lds + LDS_TOTAL - 16);
    if (threadIdx.x == 0) { xbw[0] = 0u; xbw[1] = 0u; xbw[2] = 0u; xbw[3] = 0u; }
    __syncthreads();
    char* ws = P.ws; const int gid = blockIdx.x, gsz = gridDim.x;
    int* ctrl = (int*)(ws + OFF_CTRL); float* mod = (float*)(ws + OFF_MOD); float* rope = (float*)(ws + OFF_ROPE);
#if !MK_SPLIT && !defined(MK_PROBE)
    unsigned* initflag = (unsigned*)ctrl + INIT_FLAG_WORD;
    if (gid == 0) {
        for (int i = threadIdx.x; i < INIT_ZERO_WORDS / 4; i += 512) ((u32x4*)ctrl)[i] = (u32x4){0u, 0u, 0u, 0u};
        asm volatile("s_waitcnt vmcnt(0)" ::: "memory"); __syncthreads();
        if (threadIdx.x == 0) { __builtin_amdgcn_fence(__ATOMIC_RELEASE, "agent"); asm volatile("s_waitcnt vmcnt(0)" ::: "memory"); __hip_atomic_store(initflag, INIT_MAGIC, __ATOMIC_RELAXED, __HIP_MEMORY_SCOPE_AGENT); }
    }
#else
    XcdBarrier bar = xcd_barrier_post((unsigned*)ctrl, xbw);
#endif
    int* eidx = (int*)(ws + OFF_EIDX); float* gate = (float*)(ws + OFF_GATE); int* list = (int*)(ws + OFF_LIST); int* posin = (int*)(ws + OFF_POSIN);
    char* wmix = ws + OFF_WMIX; char* wexp = ws + OFF_WEXP;
    bf16_t* h = (bf16_t*)(ws + OFF_H); bf16_t* mixed = (bf16_t*)(ws + OFF_MIXED); bf16_t* u = (bf16_t*)(ws + OFF_U); bf16_t* q = (bf16_t*)(ws + OFF_Q); bf16_t* k = (bf16_t*)(ws + OFF_K);
    bf16_t* v = (bf16_t*)(ws + OFF_V); bf16_t* sgp = (bf16_t*)(ws + OFF_SGP); bf16_t* sga = (bf16_t*)(ws + OFF_SGA); bf16_t* poolo = (bf16_t*)(ws + OFF_POOLO);
    bf16_t* attno = (bf16_t*)(ws + OFF_ATTNO); bf16_t* vt = (bf16_t*)(ws + OFF_VT); bf16_t* ypool = (bf16_t*)(ws + OFF_YPOOL); bf16_t* merged = (bf16_t*)(ws + OFF_MERGED);
    bf16_t* x1b = (bf16_t*)(ws + OFF_X1B);
    unsigned char* h2 = (unsigned char*)(ws + OFF_H2); unsigned char* act = (unsigned char*)(ws + OFF_ACT); unsigned char* yslot = (unsigned char*)(ws + OFF_YSLOT);

    PHASE(0) {
        phase_ada_rope(lds, P.c, P.w_ada, P.b_ada, mod, rope, gid);
        unsigned* buf = (unsigned*)shm;
        if (gid >= 192) {
            cvt_w8(P.w_out, D, 0, 32, 16, D, (unsigned char*)(ws + OFF_W8O), gid - 192, 64, buf);
            cvt_w8(P.w_bp, D, 0, 32, 8, 1024, (unsigned char*)(ws + OFF_W8P), gid - 192, 64, buf);
            cvt_w8(P.w_ba, D, 0, 32, 16, D, (unsigned char*)(ws + OFF_W8A), gid - 192, 64, buf); }
        cvt_mix(P.w_in, P.pool_w, P.w_bp, P.w_ba, P.w_out, wmix, WM_IN, WM_POOL, WM_BP, WM_BA, WM_OUT, gid, gsz, buf);
        cvt_w8(P.w_in, INW, 0, 176, 16, D, (unsigned char*)(ws + OFF_W8G), gid, gsz, buf);
        { bf16_t* wrt = (bf16_t*)(ws + OFF_WRT);
          for (int i = gid * 512 + threadIdx.x; i < NE * D; i += gsz * 512) { const int e = i >> 11, d = i & (D - 1); const float w = P.w_router[d * NE + e];
              const unsigned hb = mg::cvt_pk_bf16(w, 0.f) & 0xffffu; const float hf = __uint_as_float(hb << 16); wrt[i] = (bf16_t)hb; wrt[NE * D + i] = (bf16_t)(mg::cvt_pk_bf16(w - hf, 0.f) & 0xffffu); } }
    }
#if !MK_SPLIT && !defined(MK_PROBE)
    if (threadIdx.x == 0) { unsigned sp = 0u; while (__hip_atomic_load(initflag, __ATOMIC_RELAXED, __HIP_MEMORY_SCOPE_AGENT) != INIT_MAGIC) { __builtin_amdgcn_s_sleep(2); if (++sp > (1u << 22)) break; }
        __builtin_amdgcn_fence(__ATOMIC_ACQUIRE, "agent"); asm volatile("s_waitcnt vmcnt(0)" ::: "memory"); }
    __syncthreads();
    XcdBarrier bar = xcd_barrier_post((unsigned*)ctrl, xbw);
#endif
    SEAM(0);
#if !MK_SPLIT && !defined(MK_PROBE)
    if (gid == 0 && threadIdx.x == 0) __hip_atomic_store(initflag, INIT_DONE, __ATOMIC_RELAXED, __HIP_MEMORY_SCOPE_AGENT);
#endif
    PHASE(1) phase_norm_mod(P.x, P.norm1_w, mod, h, (unsigned char*)(ws + OFF_H8), gid, gsz);
    SEAM(1);
    PHASE(2) {
        if (gid < NGEMM) {
            if (threadIdx.x < 256) tbl[threadIdx.x] = (threadIdx.x == TB_TSTART + 65) ? 64 : 0;
            __syncthreads();
            mg::MoeSched<false, 44> S; S.G = NGEMM; S.c = gid; S.tb = tbl; S.list = list; S.W = (const char*)(ws + OFF_W8G) - (size_t)64 * 1024 * D;
            mg::gemm_phase<mg::EpiSigM, mg::MoeSched<false, 44>, true>(lds, (const char*)(ws + OFF_H8), D, S, mg::EpiSigM{u, q, k, v, sgp, sga, rope});
        } else cvt_experts8(P.wg, P.wu, P.wd, P.sg, P.su, P.sd, wexp, WE_GU, WE_D, gid - NGEMM, gsz - NGEMM, (unsigned*)shm); }
    SEAM(2);
    PHASE(4) {
        pool_pre_unit(u, mixed, gid >> 2, gid & 3);
        asm volatile("s_waitcnt vmcnt(0)" ::: "memory"); __syncthreads();
        { mg::PoolSched S; S.G = gsz; S.c = gid; S.Bt = wmix + WM_POOL; mg::gemm_phase<mg::EpiPool, mg::PoolSched>(lds, (const char*)mixed, 256, S, mg::EpiPool{(unsigned char*)poolo, P.pool_scale}); }
        at::attn_phase(lds, q, k, v, attno, P.lq1, P.lk1, P.lq2, P.lk2, P.subln_w, gid, gsz); }
    SEAM(4);
    PHASE(5) {
        if (threadIdx.x < 256) tbl[threadIdx.x] = (threadIdx.x == TB_TSTART + 65) ? 64 : 0;
        __syncthreads();
        { mg::MoeSched<false, 8, 1024, 1024> S; S.G = gsz; S.c = gid; S.tb = tbl; S.list = list; S.W = (const char*)(ws + OFF_W8P) - (size_t)64 * 1024 * 1024;
          mg::gemm_phase<mg::EpiGateM<0>, mg::MoeSched<false, 8, 1024, 1024>, true>(lds, (const char*)poolo, 1024, S, mg::EpiGateM<0>{(void*)ypool, sgp, nullptr}); }
        { mg::MoeSched<false, 8> S; S.G = gsz; S.c = gid; S.tb = tbl; S.list = list; S.W = (const char*)(ws + OFF_W8A) - (size_t)64 * 1024 * D;
          mg::gemm_phase<mg::EpiGateM<1>, mg::MoeSched<false, 8>, true>(lds, (const char*)attno, D, S, mg::EpiGateM<1>{(void*)merged, sga, ypool}); } }
    SEAM(5);
    PHASE(6) {
        if (threadIdx.x < 256) tbl[threadIdx.x] = (threadIdx.x == TB_TSTART + 65) ? 64 : 0;
        __syncthreads();
        mg::MoeSched<false, 8> S; S.G = gsz; S.c = gid; S.tb = tbl; S.list = list; S.W = (const char*)(ws + OFF_W8O) - (size_t)64 * 1024 * D;
        mg::gemm_phase<mg::EpiOutM, mg::MoeSched<false, 8>, true>(lds, (const char*)merged, D, S, mg::EpiOutM{x1b, P.x, mod}); }
    SEAM(6);
    PHASE(7) phase_router(lds, tbl, x1b, P.norm2_w, mod, (const bf16_t*)(ws + OFF_WRT), P.router_bias, h2, eidx, gate, ctrl, list, posin, gid, gsz);
    SEAM(7);
    PHASE(8) { moe_tables(tbl, ctrl); mg::MoeSched<false> S; S.G = gsz; S.c = gid; S.tb = tbl; S.list = list; S.W = wexp + WE_GU;
        mg::gemm_phase<mg::EpiAct, mg::MoeSched<false>, true>(lds, (const char*)h2, D, S, mg::EpiAct{act}); }
    SEAM(8);
    PHASE(9) { moe_tables(tbl, ctrl); mg::MoeSched<true> S; S.G = gsz; S.c = gid; S.tb = tbl; S.list = list; S.W = wexp + WE_D;
        mg::gemm_phase<mg::EpiDown, mg::MoeSched<true>, true>(lds, (const char*)act, ED, S, mg::EpiDown{yslot}); }
    SEAM(9);
    PHASE(10) { moe_tables(tbl, ctrl); phase_final(P.out, x1b, yslot, eidx, posin, gate, tbl, mod, P.final_w, gid, gsz); }
}

#ifndef MK_SPLIT
#define MK_SPLIT 0
#endif
extern "C" void kernel_launch(void* const* d_in, const int* in_sizes, int n_in, void* d_out, int out_size, void* d_ws, size_t ws_size, hipStream_t stream) {
    if (ws_size < WS_NEED) return;
    static int ready = 0;
    if (!ready) {
        if (hipFuncSetAttribute((const void*)fwd, hipFuncAttributeMaxDynamicSharedMemorySize, LDS_TOTAL) != hipSuccess) return;
        int per_cu = 0; if (hipOccupancyMaxActiveBlocksPerMultiprocessor(&per_cu, (const void*)fwd, 512, LDS_TOTAL) != hipSuccess || per_cu < 1) return;
        ready = 1;
    }
    Params P{};
    const float** pp = (const float**)&P; for (int i = 0; i < 26; ++i) pp[i] = (const float*)d_in[i];
    P.out = (float*)d_out; P.ws = (char*)d_ws;
#if MK_SPLIT || defined(MK_PROBE)
    (void)hipMemsetAsync(d_ws, 0, 64 * 1024, stream);
#endif
#if MK_SPLIT
    for (int ph = 0; ph < 11; ++ph) { P.p_lo = ph; P.p_hi = ph + 1; hipLaunchKernelGGL(fwd, dim3(256), dim3(512), LDS_TOTAL, stream, P); }
#elif defined(MK_PROBE)
    P.p_lo = 0; P.p_hi = MK_PROBE + 1; hipLaunchKernelGGL(fwd, dim3(256), dim3(512), LDS_TOTAL, stream, P);
    (void)hipMemsetAsync(d_ws, 0, 4096 * 4, stream);
    P.p_lo = MK_PROBE; P.p_hi = 11; hipLaunchKernelGGL(fwd, dim3(256), dim3(512), LDS_TOTAL, stream, P);
#else
    P.p_lo = 0; P.p_hi = 11; hipLaunchKernelGGL(fwd, dim3(256), dim3(512), LDS_TOTAL, stream, P);
#endif
}
```
